# Optimizing an MI355X kernel written in HIP

```python
import math
import jax
import jax.numpy as jnp
from jax import lax
import numpy as np

D_MODEL = 1024
BATCH = 4
SEQ = 4096
DEPTH = 2

GRID_W = 64
CTX_LEN = 256
N_BRANCH = 4
RMS_EPS = 1e-6
CONV_K = 3

MLSTM_HEADS = 4
MLSTM_HEAD_DIM = 128
MLSTM_WIDTH = MLSTM_HEADS * MLSTM_HEAD_DIM
MLSTM_CHUNK = 128
SGU_GROUPS = 4
SGU_GROUP_DIM = 128
SGU_WIDTH = SGU_GROUPS * SGU_GROUP_DIM
SGU_CHUNK = 128
S5_GROUP_DIM = 16
S5_GROUPS = 24
S5_WIDTH = S5_GROUPS * S5_GROUP_DIM
S5_STATE = 64
S5_DT_MIN = 1e-3
S5_DT_MAX = 1e-1
SCONV_WIDTH = 512
FFN_HIDDEN = ((8 * D_MODEL + 3 * 256 - 1) // (3 * 256)) * 256

STATE_WIDTHS = (MLSTM_WIDTH, MLSTM_WIDTH, MLSTM_WIDTH, 4 * MLSTM_HEADS, S5_WIDTH)
OUT_WIDTHS = (MLSTM_WIDTH, SGU_WIDTH, SGU_WIDTH, SCONV_WIDTH, SCONV_WIDTH, SCONV_WIDTH, N_BRANCH * D_MODEL)
STATE_DIM = sum(STATE_WIDTHS)
IN_DIM = STATE_DIM + sum(OUT_WIDTHS)

kernel_name = 'hybrid_mlstm_sgu_s5_conv_dit_trunk'


def rmsnorm(x, g):
    xf = x.astype(jnp.float32)
    y = xf * lax.rsqrt(jnp.mean(xf * xf, axis=-1, keepdims=True) + RMS_EPS)
    return (y * g.astype(jnp.float32)).astype(x.dtype)


def modulate(x, g, shift, scale):
    return rmsnorm(x, g) * (1 + scale) + shift


def swiglu(h, w_gate, w_up, w_down):
    return (jax.nn.silu(h @ w_gate) * (h @ w_up)) @ w_down


def split_cols(z, widths):
    parts, off = [], 0
    for w in widths:
        parts.append(z[..., off:off + w])
        off += w
    return parts


def conv_seq(x, w):
    t = x.shape[1]
    pad = CONV_K // 2
    xp = jnp.pad(x, ((0, 0), (pad, pad), (0, 0)))
    out = xp[:, 0:t] * w[0]
    for j in range(1, CONV_K):
        out = out + xp[:, j:j + t] * w[j]
    return out


def conv_grid_rows(x, w):
    b, t, ch = x.shape
    rows = t // GRID_W
    return conv_seq(x.reshape(b * rows, GRID_W, ch), w).reshape(b, t, ch)


def mlstm_zero_state(b):
    return (jnp.zeros((b, MLSTM_HEADS, MLSTM_HEAD_DIM, MLSTM_HEAD_DIM), jnp.float32),
            jnp.zeros((b, MLSTM_HEADS, MLSTM_HEAD_DIM), jnp.float32),
            jnp.zeros((b, MLSTM_HEADS), jnp.float32))


def mlstm_inputs(q_raw, k_raw, v_raw, gate_raw, w_conv_qk, b_gates, conv_fn):
    b, t, _ = q_raw.shape

    def heads(a):
        return a.astype(jnp.float32).reshape(b, t, MLSTM_HEADS, MLSTM_HEAD_DIM).transpose(0, 2, 1, 3)
    q = heads(jax.nn.silu(conv_fn(q_raw, w_conv_qk[0])))
    k = heads(jax.nn.silu(conv_fn(k_raw, w_conv_qk[1]))) * (MLSTM_HEAD_DIM ** -0.5)
    v = heads(v_raw)
    g = (gate_raw + b_gates).astype(jnp.float32).reshape(b, t, 4, MLSTM_HEADS).transpose(2, 0, 3, 1)
    return q, k, v, g


def mlstm_chunked(q, k, v, i_pre, f_pre, state, with_out):
    bsz, nh, t, dh = q.shape
    lc = MLSTM_CHUNK
    nc = t // lc

    def chunks(a):
        return jnp.moveaxis(a.reshape(bsz, nh, nc, lc, *a.shape[3:]), 2, 0)
    xs = (chunks(q), chunks(k), chunks(v), chunks(i_pre), chunks(jax.nn.log_sigmoid(f_pre)))
    causal = jnp.tril(jnp.ones((lc, lc), dtype=bool))

    def step(carry, inp):
        c_mat, n_vec, m = carry
        qc, kc, vc, ic, lfc = inp
        bcum = jnp.cumsum(lfc, axis=-1)
        b_last = bcum[..., -1]
        log_s = b_last[..., None] - bcum + ic
        m_new = jnp.maximum(b_last + m, jnp.max(log_s, axis=-1))
        w_s = jnp.exp(log_s - m_new[..., None])
        decay = jnp.exp(b_last + m - m_new)
        c_new = decay[..., None, None] * c_mat + jnp.einsum('bhs,bhsd,bhse->bhde', w_s, kc, vc)
        n_new = decay[..., None] * n_vec + jnp.einsum('bhs,bhsd->bhd', w_s, kc)
        if not with_out:
            return (c_new, n_new, m_new), None
        log_w = jnp.where(causal, bcum[..., :, None] - bcum[..., None, :] + ic[..., None, :], -jnp.inf)
        log_inter = bcum + m[..., None]
        m_t = jnp.maximum(log_inter, jnp.max(log_w, axis=-1))
        inter = jnp.exp(log_inter - m_t)
        s = jnp.einsum('bhtd,bhsd->bhts', qc, kc) * jnp.exp(log_w - m_t[..., None])
        num = inter[..., None] * jnp.einsum('bhtd,bhde->bhte', qc, c_mat) + jnp.einsum('bhts,bhse->bhte', s, vc)
        den = inter * jnp.einsum('bhtd,bhd->bht', qc, n_vec) + jnp.sum(s, axis=-1)
        h_t = num / jnp.maximum(jnp.abs(den), jnp.exp(-m_t))[..., None]
        return (c_new, n_new, m_new), h_t

    state, hs = lax.scan(step, state, xs)
    if not with_out:
        return None, state
    return jnp.moveaxis(hs, 0, 2).reshape(bsz, nh, t, dh), state


def mlstm_bidir(q, k, v, g, init, with_out):
    def fl(a):
        return jnp.flip(a, axis=2)
    h_f, st_f = mlstm_chunked(q, k, v, g[0], g[1], init[0], with_out)
    h_b, st_b = mlstm_chunked(fl(q), fl(k), fl(v), fl(g[2]), fl(g[3]), init[1], with_out)
    h = h_f + fl(h_b) if with_out else None
    return h, (st_f, st_b)


def spatial_gating(u, v, g, w_s, b_s):
    bsz, t, wd = v.shape
    vf = v.astype(jnp.float32)
    mu = jnp.mean(vf, axis=-1, keepdims=True)
    var = jnp.mean(jnp.square(vf - mu), axis=-1, keepdims=True)
    vn = ((vf - mu) * lax.rsqrt(var + RMS_EPS) * g.astype(jnp.float32)).astype(v.dtype)
    vg = vn.reshape(bsz, t // SGU_CHUNK, SGU_CHUNK, SGU_GROUPS, SGU_GROUP_DIM)
    mixed = jnp.einsum('gts,bnsgd->bntgd', w_s, vg) + jnp.swapaxes(b_s, 0, 1)[None, None, :, :, None]
    return u * mixed.reshape(bsz, t, wd)


def s5_discretise(a_re, a_im, log_dt, b_re, b_im):
    a_re = a_re.astype(jnp.float32)
    a_im = a_im.astype(jnp.float32)
    dt = jnp.exp(log_dt.astype(jnp.float32))[:, None]
    la_re, la_im = dt * a_re, dt * a_im
    mag = jnp.exp(la_re)
    ab_re, ab_im = mag * jnp.cos(la_im), mag * jnp.sin(la_im)
    nr, ni = ab_re - 1.0, ab_im
    den = a_re * a_re + a_im * a_im
    f_re = ((nr * a_re + ni * a_im) / den)[..., None]
    f_im = ((ni * a_re - nr * a_im) / den)[..., None]
    b_re = b_re.astype(jnp.float32)
    b_im = b_im.astype(jnp.float32)
    bb_re = f_re * b_re - f_im * b_im
    bb_im = f_re * b_im + f_im * b_re
    return la_re, la_im, ab_re, ab_im, bb_re, bb_im


def s5_drive(u, bb_re, bb_im):
    bsz, t, _ = u.shape
    ug = u.reshape(bsz, t, S5_GROUPS, S5_GROUP_DIM)
    return jnp.einsum('btgj,gpj->btgp', ug, bb_re), jnp.einsum('btgj,gpj->btgp', ug, bb_im)


def s5_combine(e1, e2):
    a1r, a1i, b1r, b1i = e1
    a2r, a2i, b2r, b2i = e2
    return (a2r * a1r - a2i * a1i, a2r * a1i + a2i * a1r,
            a2r * b1r - a2i * b1i + b2r, a2r * b1i + a2i * b1r + b2i)


def s5_states(u, disc, x0, reverse):
    _, _, ab_re, ab_im, bb_re, bb_im = disc
    bu_re, bu_im = s5_drive(u, bb_re, bb_im)
    if reverse:
        bu_re, bu_im = jnp.flip(bu_re, axis=1), jnp.flip(bu_im, axis=1)
    if x0 is not None:
        x0_re, x0_im = x0
        bu_re = bu_re.at[:, 0].add(ab_re * x0_re - ab_im * x0_im)
        bu_im = bu_im.at[:, 0].add(ab_re * x0_im + ab_im * x0_re)
    t = u.shape[1]
    a_re_t = jnp.broadcast_to(ab_re, (1, t) + ab_re.shape)
    a_im_t = jnp.broadcast_to(ab_im, (1, t) + ab_im.shape)
    _, _, xr, xi = lax.associative_scan(s5_combine, (a_re_t, a_im_t, bu_re, bu_im), axis=1)
    if reverse:
        xr, xi = jnp.flip(xr, axis=1), jnp.flip(xi, axis=1)
    return xr, xi


def s5_final_state(u, disc, reverse):
    la_re, la_im, _, _, bb_re, bb_im = disc
    bu_re, bu_im = s5_drive(u, bb_re, bb_im)
    t = u.shape[1]
    pos = jnp.arange(t, dtype=jnp.float32)
    steps = pos if reverse else (t - 1) - pos
    mag = jnp.exp(steps[:, None, None] * la_re)
    ang = steps[:, None, None] * la_im
    p_re, p_im = mag * jnp.cos(ang), mag * jnp.sin(ang)
    x_re = jnp.einsum('tgp,btgp->bgp', p_re, bu_re) - jnp.einsum('tgp,btgp->bgp', p_im, bu_im)
    x_im = jnp.einsum('tgp,btgp->bgp', p_re, bu_im) + jnp.einsum('tgp,btgp->bgp', p_im, bu_re)
    return x_re, x_im


def s5_out(xr, xi, u, c_re, c_im, d, w_glu, b_glu, dtype):
    bsz, t, _ = u.shape
    y = (jnp.einsum('gjp,btgp->btgj', c_re.astype(jnp.float32), xr)
         - jnp.einsum('gjp,btgp->btgj', c_im.astype(jnp.float32), xi))
    y = y.reshape(bsz, t, S5_WIDTH) + d.astype(jnp.float32) * u
    y = jax.nn.gelu(y).astype(dtype)
    return y * jax.nn.sigmoid(y @ w_glu + b_glu)


def merge_branches(o_cols, h_mlstm, y_s5, conv_fn, g_mh, g_sgu, w_sgu, b_sgu, w_sconv,
                   w_up_mlstm, w_up_sgu, w_up_s5, w_up_sconv, w_out):
    o_raw, su, sv, cb, cc, cx, gate_raw = o_cols
    bsz, t, _ = o_raw.shape
    hm = jnp.transpose(h_mlstm, (0, 2, 1, 3))
    hm = hm * lax.rsqrt(jnp.mean(hm * hm, axis=-1, keepdims=True) + RMS_EPS)
    hm = (hm.reshape(bsz, t, MLSTM_WIDTH) * g_mh.astype(jnp.float32)).astype(o_raw.dtype)
    y_a = hm * jax.nn.sigmoid(o_raw)
    y_b = spatial_gating(jax.nn.gelu(su), jax.nn.gelu(sv), g_sgu, w_sgu, b_sgu)
    y_d = cb * conv_fn(cc * cx, w_sconv)
    gates = jax.nn.sigmoid(gate_raw.reshape(bsz, t, N_BRANCH, D_MODEL))
    merged = (gates[:, :, 0] * (y_a @ w_up_mlstm) + gates[:, :, 1] * (y_b @ w_up_sgu)
              + gates[:, :, 2] * (y_s5 @ w_up_s5) + gates[:, :, 3] * (y_d @ w_up_sconv))
    return merged @ w_out


def token_mixer(hx, hc, need_ctx, w_in, b_gates, w_conv_qk, g_mh, g_sgu, w_sgu, b_sgu,
                s5_a_re, s5_a_im, s5_log_dt, s5_b_re, s5_b_im, s5_c_re, s5_c_im, s5_d,
                w_glu, b_glu, w_sconv, w_up_mlstm, w_up_sgu, w_up_s5, w_up_sconv, w_out):
    bsz = hx.shape[0]
    zx = hx @ w_in
    zc = hc @ (w_in if need_ctx else w_in[:, :STATE_DIM])
    qx, kx, vx, gx, ux = split_cols(zx[..., :STATE_DIM], STATE_WIDTHS)
    qc, kc, vc, gc, uc = split_cols(zc[..., :STATE_DIM], STATE_WIDTHS)

    mc = mlstm_inputs(qc, kc, vc, gc, w_conv_qk, b_gates, conv_seq)
    h_mc, st_ctx = mlstm_bidir(*mc, (mlstm_zero_state(bsz), mlstm_zero_state(bsz)), need_ctx)
    mx = mlstm_inputs(qx, kx, vx, gx, w_conv_qk, b_gates, conv_grid_rows)
    h_mx, _ = mlstm_bidir(*mx, st_ctx, True)

    discs = [s5_discretise(s5_a_re[d], s5_a_im[d], s5_log_dt[d], s5_b_re, s5_b_im) for d in range(2)]
    uc32 = uc.astype(jnp.float32)
    ux32 = ux.astype(jnp.float32)
    if need_ctx:
        sc_f = s5_states(uc32, discs[0], None, False)
        sc_b = s5_states(uc32, discs[1], None, True)
        x0s = ((sc_f[0][:, -1], sc_f[1][:, -1]), (sc_b[0][:, 0], sc_b[1][:, 0]))
        y_s5c = s5_out(sc_f[0] + sc_b[0], sc_f[1] + sc_b[1], uc32, s5_c_re, s5_c_im, s5_d, w_glu, b_glu, hc.dtype)
    else:
        x0s = (s5_final_state(uc32, discs[0], False), s5_final_state(uc32, discs[1], True))
    sx_f = s5_states(ux32, discs[0], x0s[0], False)
    sx_b = s5_states(ux32, discs[1], x0s[1], True)
    y_s5x = s5_out(sx_f[0] + sx_b[0], sx_f[1] + sx_b[1], ux32, s5_c_re, s5_c_im, s5_d, w_glu, b_glu, hx.dtype)

    shared = (g_mh, g_sgu, w_sgu, b_sgu, w_sconv, w_up_mlstm, w_up_sgu, w_up_s5, w_up_sconv, w_out)
    yx = merge_branches(split_cols(zx[..., STATE_DIM:], OUT_WIDTHS), h_mx, y_s5x, conv_grid_rows, *shared)
    yc = None
    if need_ctx:
        yc = merge_branches(split_cols(zc[..., STATE_DIM:], OUT_WIDTHS), h_mc, y_s5c, conv_seq, *shared)
    return yx, yc


def setup_inputs(seed: int = 0) -> dict:
    key = jax.random.key(seed)
    ks = iter(jax.random.split(key, 48))

    def nrm(shape, scale):
        return jax.random.normal(next(ks), shape, jnp.float32) * scale
    L, D = DEPTH, D_MODEL
    f_bias = jnp.linspace(3.0, 6.0, MLSTM_HEADS, dtype=jnp.float32)
    i_bias = jnp.zeros((MLSTM_HEADS,), jnp.float32)
    gate_bias = jnp.concatenate([i_bias, f_bias, i_bias, f_bias])
    n_idx = jnp.arange(S5_STATE, dtype=jnp.float32)
    return {
        'x': nrm((BATCH, SEQ, D), 1.0),
        'c': nrm((BATCH, D), 1.0),
        'ctx': nrm((BATCH, CTX_LEN, D), 1.0),
        'c_ctx': nrm((D,), 1.0),
        'w_mod': nrm((L, D, 6 * D), 0.5 * D ** -0.5),
        'b_mod': nrm((L, 6 * D), 0.02),
        'g_norm_mix': 1.0 + nrm((L, D), 0.02),
        'g_norm_ffn': 1.0 + nrm((L, D), 0.02),
        'w_in': nrm((L, D, IN_DIM), D ** -0.5),
        'b_gates': gate_bias[None, :] + nrm((L, 4 * MLSTM_HEADS), 0.1),
        'w_conv_qk': nrm((L, 2, CONV_K, MLSTM_WIDTH), CONV_K ** -0.5),
        'g_mh': 1.0 + nrm((L, MLSTM_WIDTH), 0.02),
        'g_sgu': 1.0 + nrm((L, SGU_WIDTH), 0.02),
        'w_sgu': nrm((L, SGU_GROUPS, SGU_CHUNK, SGU_CHUNK), SGU_CHUNK ** -0.5),
        'b_sgu': 1.0 + nrm((L, SGU_GROUPS, SGU_CHUNK), 0.02),
        's5_a_re': -0.5 + nrm((L, 2, S5_GROUPS, S5_STATE), 0.01),
        's5_a_im': math.pi * n_idx + nrm((L, 2, S5_GROUPS, S5_STATE), 0.01),
        's5_log_dt': jax.random.uniform(next(ks), (L, 2, S5_GROUPS), jnp.float32,
                                        math.log(S5_DT_MIN), math.log(S5_DT_MAX)),
        's5_b_re': nrm((L, S5_GROUPS, S5_STATE, S5_GROUP_DIM), (2 * S5_GROUP_DIM) ** -0.5),
        's5_b_im': nrm((L, S5_GROUPS, S5_STATE, S5_GROUP_DIM), (2 * S5_GROUP_DIM) ** -0.5),
        's5_c_re': nrm((L, S5_GROUPS, S5_GROUP_DIM, S5_STATE), S5_STATE ** -0.5),
        's5_c_im': nrm((L, S5_GROUPS, S5_GROUP_DIM, S5_STATE), S5_STATE ** -0.5),
        's5_d': nrm((L, S5_WIDTH), 1.0),
        'w_glu': nrm((L, S5_WIDTH, S5_WIDTH), S5_WIDTH ** -0.5),
        'b_glu': nrm((L, S5_WIDTH), 0.02),
        'w_sconv': nrm((L, CONV_K, SCONV_WIDTH), CONV_K ** -0.5),
        'w_up_mlstm': nrm((L, MLSTM_WIDTH, D), MLSTM_WIDTH ** -0.5),
        'w_up_sgu': nrm((L, SGU_WIDTH, D), SGU_WIDTH ** -0.5),
        'w_up_s5': nrm((L, S5_WIDTH, D), S5_WIDTH ** -0.5),
        'w_up_sconv': nrm((L, SCONV_WIDTH, D), SCONV_WIDTH ** -0.5),
        'w_out': nrm((L, D, D), D ** -0.5),
        'w_ffn_gate': nrm((L, D, FFN_HIDDEN), D ** -0.5),
        'w_ffn_up': nrm((L, D, FFN_HIDDEN), D ** -0.5),
        'w_ffn_down': nrm((L, FFN_HIDDEN, D), FFN_HIDDEN ** -0.5),
        'g_final': 1.0 + nrm((D,), 0.02),
    }


def reference(x, c, ctx, c_ctx, w_mod, b_mod, g_norm_mix, g_norm_ffn, w_in, b_gates,
              w_conv_qk, g_mh, g_sgu, w_sgu, b_sgu, s5_a_re, s5_a_im, s5_log_dt,
              s5_b_re, s5_b_im, s5_c_re, s5_c_im, s5_d, w_glu, b_glu, w_sconv,
              w_up_mlstm, w_up_sgu, w_up_s5, w_up_sconv, w_out,
              w_ffn_gate, w_ffn_up, w_ffn_down, g_final):
    D = D_MODEL
    xc = ctx
    sc_x = jax.nn.silu(c)
    sc_c = jax.nn.silu(c_ctx)
    for l in range(DEPTH):
        last = l == DEPTH - 1
        mod_x = jnp.split((sc_x @ w_mod[l] + b_mod[l])[:, None, :], 6, axis=-1)
        n_mod = 2 if last else 6
        mod_c = jnp.split((sc_c @ w_mod[l][:, :n_mod * D] + b_mod[l][:n_mod * D])[None, None, :], n_mod, axis=-1)
        hx = modulate(x, g_norm_mix[l], mod_x[0], mod_x[1])
        hc = modulate(xc, g_norm_mix[l], mod_c[0], mod_c[1])
        yx, yc = token_mixer(hx, hc, not last, w_in[l], b_gates[l], w_conv_qk[l], g_mh[l], g_sgu[l],
                             w_sgu[l], b_sgu[l], s5_a_re[l], s5_a_im[l], s5_log_dt[l], s5_b_re[l],
                             s5_b_im[l], s5_c_re[l], s5_c_im[l], s5_d[l], w_glu[l], b_glu[l],
                             w_sconv[l], w_up_mlstm[l], w_up_sgu[l], w_up_s5[l], w_up_sconv[l], w_out[l])
        x = x + mod_x[2] * yx
        x = x + mod_x[5] * swiglu(modulate(x, g_norm_ffn[l], mod_x[3], mod_x[4]),
                                  w_ffn_gate[l], w_ffn_up[l], w_ffn_down[l])
        if not last:
            xc = xc + mod_c[2] * yc
            xc = xc + mod_c[5] * swiglu(modulate(xc, g_norm_ffn[l], mod_c[3], mod_c[4]),
                                        w_ffn_gate[l], w_ffn_up[l], w_ffn_down[l])
    return rmsnorm(x, g_final)
```

```cpp
#include <hip/hip_runtime.h>
#include <hip/hip_cooperative_groups.h>
#include <cstdio>
#include <cstdint>
namespace cg = cooperative_groups;

#ifndef MASK
#define MASK 31
#endif

#define GAS __attribute__((address_space(1)))
#define LAS __attribute__((address_space(3)))
typedef unsigned short bf16;
typedef float f32x4 __attribute__((ext_vector_type(4)));
typedef float f32x2 __attribute__((ext_vector_type(2)));
typedef short bf16x8 __attribute__((ext_vector_type(8)));
typedef unsigned u32x4 __attribute__((ext_vector_type(4)));
typedef unsigned u32x2 __attribute__((ext_vector_type(2)));

constexpr int NWAVES = 8, NTHR = 512;
constexpr int D = 1024, BATCH = 4, SEQ = 4096, CTXL = 256, DEPTH = 2;
constexpr int MLAT = BATCH * SEQ, MCTX = BATCH * CTXL, MTOT = MLAT + MCTX;
constexpr int IN_DIM = 9104, ZW = 9216, FFH = 2816, FF2 = 2 * FFH;
constexpr int NGRP = 2, GROWS = MTOT / NGRP;
constexpr float RMS_EPS = 1e-6f;
enum { I_X = 0, I_C, I_CTX, I_CCTX, I_WMOD, I_BMOD, I_GNMIX, I_GNFFN, I_WIN, I_BGATES, I_WCONVQK, I_GMH, I_GSGU, I_WSGU, I_BSGU,
       I_S5ARE, I_S5AIM, I_S5LOGDT, I_S5BRE, I_S5BIM, I_S5CRE, I_S5CIM, I_S5D, I_WGLU, I_BGLU, I_WSCONV, I_WUPM, I_WUPSGU, I_WUPS5, I_WUPSC,
       I_WOUT, I_WFFG, I_WFFU, I_WFFD, I_GFINAL, N_IN };

constexpr size_t MiB = 1u << 20;
constexpr size_t WS_CTL = 0, CTL_ZERO_BYTES = 1 * MiB;
constexpr size_t WS_MOD = 1 * MiB;
constexpr size_t WS_WIN = 2 * MiB;
constexpr size_t WS_WUP = 20 * MiB;
constexpr size_t WS_WOUT = 24 * MiB;
constexpr size_t WS_WFF1 = 26 * MiB;
constexpr size_t WS_WFF2 = 37 * MiB;
constexpr size_t WS_WGLU = 43 * MiB;
constexpr size_t WS_S5T = 43 * MiB + 320 * 1024;
constexpr size_t WS_XC = 44 * MiB;
constexpr size_t WS_HN = 48 * MiB;
constexpr size_t WS_MST = 82 * MiB;
constexpr size_t WS_S5E = 116 * MiB;
constexpr size_t WS_MISC = 123 * MiB;
constexpr size_t WS_ZX = 126 * MiB;
constexpr size_t WS_END = 279 * MiB;
constexpr int CW_BAR = 4096;

constexpr int LDS_BYTES = 147456;
constexpr int LDSCTL_OFF = LDS_BYTES - 512, MISC_OFF = LDSCTL_OFF + 320;

namespace pg8 {
#define PG8_LAS __attribute__((address_space(3)))
typedef unsigned short bf16_t;
constexpr int BM = 256, BK = 64, HALF = 128, HTB = HALF * BK * 2, STAGE_BYTES = 8 * HTB, NXCD = 8, WGM = 8;
__host__ __device__ __forceinline__ int lds_byte(int r, int c) { const int st = (r >> 4) * 2 + (c >> 5), rr = r & 15, cc = c & 31, ob = rr * 64 + cc * 2; return st * 1024 + (ob ^ (((ob >> 9) & 1) << 5)); }
__host__ __device__ __forceinline__ void stage_rc(int b, int& R, int& C) { const int st = b / 1024, sb = b % 1024, swz = sb ^ (((sb >> 9) & 1) << 5); R = (st >> 1) * 16 + swz / 64; C = (st & 1) * 32 + (swz % 64) / 2; }
__host__ __device__ __forceinline__ int perm32(int rho) { const int n = rho >> 4, i = rho & 15; return 8 * (i >> 2) + 4 * n + (i & 3); }

struct Unit { int pm, pn; const char* A; const char* B; int nt; int pmg; int br; };
struct Ld { int lda, ldb; };
__device__ __forceinline__ void tile_of(int L, int nM, int nN, int& pm, int& pn) {
    const int nwg = nM * nN; int wgid = L; { const int q = nwg / NXCD, r = nwg % NXCD, xcd = wgid % NXCD, off = wgid / NXCD; wgid = (xcd < r ? xcd * (q + 1) : r * (q + 1) + (xcd - r) * q) + off; }
    const int nig = WGM * nN, gid = wgid / nig, fm = gid * WGM, gsz = (nM - fm) < WGM ? (nM - fm) : WGM;
    pm = fm + ((wgid % nig) % gsz); pn = (wgid % nig) / gsz;
}
__device__ __forceinline__ unsigned cvt_pk_bf16(float lo, float hi) { unsigned r; asm volatile("v_cvt_pk_bf16_f32 %0, %1, %2" : "=v"(r) : "v"(lo), "v"(hi)); return r; }

__device__ __forceinline__ size_t kcat_off(int t) { return t < 8 ? (size_t)2048 * 2 + t * 128 : t < 16 ? (size_t)2560 * 2 + (t - 8) * 128 : t < 22 ? (size_t)1536 * 2 + (t - 16) * 128 : (size_t)3584 * 2 + (t - 22) * 128; }
template <class Epi, class Sched, int LDA, int LDB, bool ALIGN_EPI = true, bool SP2 = true, bool KCAT = false>
__device__ __forceinline__ void gemm_phase(PG8_LAS unsigned char* lds, const Sched& S, const Epi& E) {
    int tid = threadIdx.x; asm volatile("" : "+v"(tid));
    const int wid = __builtin_amdgcn_readfirstlane(tid >> 6), lane = tid & 63, wr = wid >> 2, wc = wid & 3, fr = lane & 15, fq = lane >> 4;
    unsigned voffA[2], voffB[2];
#pragma unroll
    for (int i = 0; i < 2; ++i) { int R, C; stage_rc(tid * 16 + i * 8192, R, C); const int Rb = Epi::PERM ? ((R & ~31) + perm32(R & 31)) : R;
        voffA[i] = (unsigned)(R * LDA + C) * 2u; voffB[i] = (unsigned)(Rb * LDB + C) * 2u; }
    const size_t kstep = (size_t)(BK * 2);
    constexpr size_t hstepA = (size_t)HALF * LDA * 2, hstepB = (size_t)HALF * LDB * 2;
    const unsigned ldsw = (unsigned)wid * 1024u;
    const int aoff = lds_byte(wr * 64 + fr, fq * 8), boff = lds_byte(wc * 32 + fr, fq * 8);
#define PG8_SA(b, h) (((b) * 2 + (h)) * HTB)
#define PG8_SB(b, h) ((4 + (b) * 2 + (h)) * HTB)
#define PG8_STAGE(bufoff, gbase, voff) do { _Pragma("unroll") for (int _i = 0; _i < 2; ++_i) \
        __builtin_amdgcn_global_load_lds((const unsigned*)((const char*)(gbase) + (voff)[_i]), (PG8_LAS unsigned*)(lds + (bufoff) + ldsw + _i * 8192), 16, 0, 0); } while (0)
#define PG8_LDA(dst, b, h) do { _Pragma("unroll") for (int m = 0; m < 4; ++m) _Pragma("unroll") for (int k = 0; k < 2; ++k) dst[m][k] = *(const PG8_LAS bf16x8*)(lds + PG8_SA(b, h) + aoff + m * 2048 + k * 1024); } while (0)
#define PG8_LDB(dst, b, h) do { _Pragma("unroll") for (int n = 0; n < 2; ++n) _Pragma("unroll") for (int k = 0; k < 2; ++k) dst[n][k] = *(const PG8_LAS bf16x8*)(lds + PG8_SB(b, h) + boff + n * 2048 + k * 1024); } while (0)
#define PG8_MMA(ai, bj, At, Bt) do { __builtin_amdgcn_s_setprio(1); _Pragma("unroll") for (int m = 0; m < 4; ++m) _Pragma("unroll") for (int n = 0; n < 2; ++n) _Pragma("unroll") for (int k = 0; k < 2; ++k) \
        acc[ai][bj][m][n] = __builtin_amdgcn_mfma_f32_16x16x32_bf16(Bt[n][k], At[m][k], acc[ai][bj][m][n], 0, 0, 0); __builtin_amdgcn_s_setprio(0); } while (0)
#define PG8_WAIT_V(n) asm volatile("s_waitcnt vmcnt(" #n ")" ::: "memory")
#define PG8_WAIT_L(n) asm volatile("s_waitcnt lgkmcnt(" #n ")" ::: "memory")
#define PG8_BAR __builtin_amdgcn_s_barrier()
#define PG8_SCHED __builtin_amdgcn_sched_barrier(0)
    Unit cur, nxt; int ui = 0;
    if (!S.next(0, cur)) return;
    f32x4 acc[2][2][4][2];
#pragma unroll
    for (int a = 0; a < 2; ++a)
#pragma unroll
        for (int b = 0; b < 2; ++b)
#pragma unroll
            for (int m = 0; m < 4; ++m)
#pragma unroll
                for (int n = 0; n < 2; ++n) acc[a][b][m][n] = (f32x4){0.f, 0.f, 0.f, 0.f};
    bf16x8 At[4][2], B0[2][2], B1[2][2];
    const char* cA = cur.A; const char* cB = cur.B;
    static_assert(SP2, "only the SP2 loop is kept");
    const char* pA0 = KCAT ? cA + kcat_off(0) : cA; const char* pA1 = KCAT ? cA + kcat_off(1) : cA + kstep;
    PG8_STAGE(PG8_SB(0, 0), cB, voffB); PG8_STAGE(PG8_SB(0, 1), cB + hstepB, voffB); PG8_STAGE(PG8_SA(0, 0), pA0, voffA); PG8_STAGE(PG8_SA(0, 1), pA0 + hstepA, voffA);
    if (wr == 1) PG8_BAR;
    PG8_WAIT_V(2); PG8_BAR;
    PG8_STAGE(PG8_SB(1, 0), cB + kstep, voffB); PG8_STAGE(PG8_SA(1, 0), pA1, voffA); PG8_STAGE(PG8_SB(1, 1), cB + hstepB + kstep, voffB);
    PG8_WAIT_V(6); PG8_BAR;
    for (;;) {
        const bool has_next = S.next(ui + 1, nxt);
        const char* nA = has_next ? nxt.A : cA; const char* nB = has_next ? nxt.B : cB;
        const int nt = cur.nt;
        for (int t = 0; t < nt; t += 2) {
            const bool last = (t == nt - 2);
            const char* a1; const char* a2; const char* a3;
            if constexpr (KCAT) { if (t == 8 || t == 16 || t == 22) E.rescale(acc, cur, t, wr, wc, fr, fq);
                a1 = cA + kcat_off(t + 1); a2 = last ? nA + kcat_off(0) : cA + kcat_off(t + 2); a3 = last ? nA + kcat_off(1) : cA + kcat_off(t + 3); }
            else { a1 = cA + (size_t)(t + 1) * kstep; a2 = last ? nA : cA + (size_t)(t + 2) * kstep; a3 = a2 + kstep; }
            const char* b2 = last ? nB : cB + (size_t)(t + 2) * kstep; const char* b3 = b2 + kstep;
            PG8_LDB(B0, 0, 0); PG8_LDB(B1, 0, 1); PG8_SCHED; PG8_LDA(At, 0, 0); PG8_STAGE(PG8_SA(1, 1), a1 + hstepA, voffA);
            PG8_WAIT_V(8); PG8_WAIT_L(0); PG8_BAR; PG8_MMA(0, 0, At, B0); PG8_MMA(0, 1, At, B1); PG8_BAR; PG8_SCHED;
            PG8_LDA(At, 0, 1); PG8_STAGE(PG8_SB(0, 0), b2, voffB); PG8_STAGE(PG8_SB(0, 1), b2 + hstepB, voffB); PG8_STAGE(PG8_SA(0, 0), a2, voffA);
            PG8_WAIT_V(8); PG8_WAIT_L(0); PG8_BAR; PG8_MMA(1, 0, At, B0); PG8_MMA(1, 1, At, B1); PG8_BAR; PG8_SCHED;
            PG8_LDB(B0, 1, 0); PG8_LDB(B1, 1, 1); PG8_SCHED; PG8_LDA(At, 1, 0); PG8_STAGE(PG8_SA(0, 1), a2 + hstepA, voffA);
            PG8_WAIT_V(8); PG8_WAIT_L(0); PG8_BAR; PG8_MMA(0, 0, At, B0); PG8_MMA(0, 1, At, B1); PG8_BAR; PG8_SCHED;
            PG8_LDA(At, 1, 1); PG8_STAGE(PG8_SB(1, 0), b3, voffB); PG8_STAGE(PG8_SB(1, 1), b3 + hstepB, voffB); PG8_STAGE(PG8_SA(1, 0), a3, voffA);
            PG8_WAIT_V(8); PG8_WAIT_L(0); PG8_BAR; PG8_MMA(1, 0, At, B0); PG8_MMA(1, 1, At, B1); PG8_BAR; PG8_SCHED;
        }
        if constexpr (ALIGN_EPI) { if (wr == 0) PG8_BAR; }
        E(acc, cur, wr, wc, fr, fq);
        if (!has_next) break;
#pragma unroll
        for (int a = 0; a < 2; ++a)
#pragma unroll
            for (int b = 0; b < 2; ++b)
#pragma unroll
                for (int m = 0; m < 4; ++m)
#pragma unroll
                    for (int n = 0; n < 2; ++n) acc[a][b][m][n] = (f32x4){0.f, 0.f, 0.f, 0.f};
        cur = nxt; cA = nA; cB = nB; ++ui;
        if constexpr (ALIGN_EPI) { if (wr == 1) PG8_BAR; }
    }
    PG8_WAIT_V(0);
    if constexpr (!ALIGN_EPI) { if (wr == 0) PG8_BAR; }
    PG8_BAR;
#undef PG8_SA
#undef PG8_SB
#undef PG8_STAGE
#undef PG8_LDA
#undef PG8_LDB
#undef PG8_MMA
#undef PG8_WAIT_V
#undef PG8_WAIT_L
#undef PG8_BAR
#undef PG8_SCHED
}
}

#define RLX_AGENT __ATOMIC_RELAXED, __HIP_MEMORY_SCOPE_AGENT
#define LDS_WAIT() asm volatile("s_waitcnt lgkmcnt(0)" ::: "memory")
#define VM_WAIT() asm volatile("s_waitcnt vmcnt(0)" ::: "memory")
typedef __bf16 bf16x2_t __attribute__((ext_vector_type(2)));
__device__ __forceinline__ unsigned pk2(float lo, float hi) { f32x2 v = {lo, hi}; bf16x2_t b = __builtin_convertvector(v, bf16x2_t); return __builtin_bit_cast(unsigned, b); }
__device__ __forceinline__ unsigned f2bf(float f) { return pk2(f, 0.f) & 0xffffu; }
__device__ __forceinline__ float bf2f(unsigned short h) { return __builtin_bit_cast(float, (unsigned)h << 16); }
__device__ __forceinline__ u32x4 zero4() { unsigned z = 0u; asm volatile("" : "+v"(z)); return (u32x4){z, z, z, z}; }
__device__ __forceinline__ float rcpf_(float x) { return __builtin_amdgcn_rcpf(x); }
__device__ __forceinline__ float sigmoidf_(float x) { return rcpf_(1.0f + __expf(-x)); }
__device__ __forceinline__ float siluf_(float x) { return x * rcpf_(1.0f + __expf(-x)); }

#define XB_TMO      128
#define XB_XCNT(j)  (256  + 64 * (j))
#define XB_XSUB(j)  (1280 + 64 * (j))
#define XB_XGEN(j)  (2304 + 64 * (j))
#define XB_TOP      3328
#define XB_TOPGEN   3392
#define XCD_BAR_WORDS 3456
#define XB_SPIN_CAP (1u << 18)
__device__ __forceinline__ unsigned xb_ld(unsigned* p)              { return __hip_atomic_load(p, __ATOMIC_RELAXED, __HIP_MEMORY_SCOPE_AGENT); }
__device__ __forceinline__ unsigned xb_add(unsigned* p, unsigned v) { return __hip_atomic_fetch_add(p, v, __ATOMIC_RELAXED, __HIP_MEMORY_SCOPE_AGENT); }
__device__ __forceinline__ unsigned xb_xcc_id() { return (unsigned)__builtin_amdgcn_s_getreg((3 << 11) | 20) & 0xFu; }
#define XB_SPIN(cond, bar) do { unsigned _sp = 0; while (cond) { __builtin_amdgcn_s_sleep(1); \
    if ((++_sp & 255u) == 0u) { if (xb_ld(&(bar)[XB_TMO])) break; if (_sp > XB_SPIN_CAP) { atomicAdd(&(bar)[XB_TMO], 1u); break; } } } } while (0)
struct XcdBarrier { unsigned* bar; unsigned x; volatile LAS unsigned* st; };
__device__ __forceinline__ XcdBarrier xcd_barrier_post(unsigned* bar, volatile LAS unsigned* st) {
    XcdBarrier b; b.bar = bar; b.x = xb_xcc_id(); b.st = st;
    if (threadIdx.x == 0) (void)xb_add(&bar[XB_XCNT(b.x)], 1u);
    return b;
}
__device__ __forceinline__ void xcd_barrier_complete(unsigned* bar, unsigned x, unsigned& nloc, unsigned& nx) {
    const unsigned G = gridDim.x * gridDim.y * gridDim.z;
    unsigned sum, cnt, mine, sp = 0u;
    for (;;) {
        sum = 0u; cnt = 0u; mine = 0u;
#pragma unroll
        for (unsigned j = 0; j < 16; ++j) { const unsigned c = xb_ld(&bar[XB_XCNT(j)]); sum += c; cnt += (c > 0u) ? 1u : 0u; mine = (j == x) ? c : mine; }
        if (sum == G) break;
        __builtin_amdgcn_s_sleep(1);
        if ((++sp & 255u) == 0u) { if (xb_ld(&bar[XB_TMO])) break; if (sp > XB_SPIN_CAP) { atomicAdd(&bar[XB_TMO], 1u); break; } }
    }
    nloc = mine > 0u ? mine : 1u; nx = cnt > 0u ? cnt : 1u;
}
__device__ __forceinline__ void xcd_barrier(const XcdBarrier& b) {
    asm volatile("s_waitcnt vmcnt(0)" ::: "memory");
    __syncthreads();
    if (threadIdx.x == 0) {
        unsigned* bar = b.bar;
        __builtin_amdgcn_s_waitcnt(0);
        unsigned nloc = b.st[0], nx = b.st[1];
        if (nloc == 0u) { xcd_barrier_complete(bar, b.x, nloc, nx); b.st[0] = nloc; b.st[1] = nx; }
        const unsigned old = xb_add(&bar[XB_XSUB(b.x)], 1u);
        const unsigned gen = old / nloc;
        if (old + 1u == (gen + 1u) * nloc) {
            __builtin_amdgcn_fence(__ATOMIC_RELEASE, "agent");
            asm volatile("s_waitcnt vmcnt(0)" ::: "memory");
            const unsigned og = xb_add(&bar[XB_TOP], 1u);
            const unsigned tg = og / nx;
            if (og + 1u == (tg + 1u) * nx) xb_add(&bar[XB_TOPGEN], 1u);
            else XB_SPIN(xb_ld(&bar[XB_TOPGEN]) == tg, bar);
            __builtin_amdgcn_fence(__ATOMIC_ACQUIRE, "agent");
            xb_add(&bar[XB_XGEN(b.x)], 1u);
            asm volatile("s_waitcnt vmcnt(0)" ::: "memory");
        } else {
            XB_SPIN(xb_ld(&bar[XB_XGEN(b.x)]) == gen, bar);
            __builtin_amdgcn_fence(__ATOMIC_ACQUIRE, "agent");
            asm volatile("s_waitcnt vmcnt(0)" ::: "memory");
        }
    }
    __syncthreads();
}

__device__ __forceinline__ float wave_sum(float v) {
#pragma unroll
    for (int o = 1; o < 64; o <<= 1) v += __shfl_xor(v, o);
    return v;
}

#define PHASE_IDS() int tid = threadIdx.x; asm volatile("" : "+v"(tid)); const int lane = tid & 63; const int wave = __builtin_amdgcn_readfirstlane(tid >> 6); (void)lane; (void)wave
struct Args { const float* in[N_IN]; float* out; unsigned char* ws; };
struct Frame {
    LAS unsigned char* lds;
    int vcu, G;
    const float* const* in;
    float* out; unsigned char* ws;
};
__device__ __forceinline__ const float* modp(Frame& F, int l, int mb, int k) { return (const float*)(F.ws + WS_MOD) + ((size_t)(l * 5 + mb) * 6 + k) * D; }
__device__ __forceinline__ int mb_of_tile(int pmg) { return pmg < 64 ? (pmg >> 4) : 4; }

__device__ __forceinline__ void p0_mods(Frame& F) {
    PHASE_IDS();
    LAS float* sc = (LAS float*)F.lds;
    LAS float* red = sc + 5 * D;
    for (int i = tid; i < 5 * D; i += NTHR) { const float v = i < 4 * D ? F.in[I_C][i] : F.in[I_CCTX][i - 4 * D]; sc[i] = siluf_(v); }
    __syncthreads();
    for (int item = F.vcu; item < 2 * 96; item += F.G) {
        const int l = item / 96, j = (item % 96) * 64 + lane;
        const float* W = F.in[I_WMOD] + (size_t)l * D * 6 * D + j;
        float a0 = 0.f, a1 = 0.f, a2 = 0.f, a3 = 0.f, a4 = 0.f;
        const int k0 = wave * 128;
#pragma unroll 32
        for (int k = k0; k < k0 + 128; ++k) { const float w = W[(size_t)k * 6 * D]; a0 += sc[k] * w; a1 += sc[D + k] * w; a2 += sc[2 * D + k] * w; a3 += sc[3 * D + k] * w; a4 += sc[4 * D + k] * w; }
        LAS float* r = red + wave * 320 + lane;
        r[0] = a0; r[64] = a1; r[128] = a2; r[192] = a3; r[256] = a4;
        __syncthreads();
        if (tid < 320) { const int mb = tid >> 6, jj = tid & 63; float s = 0.f;
#pragma unroll
            for (int w = 0; w < 8; ++w) s += red[w * 320 + mb * 64 + jj];
            const int jc = (item % 96) * 64 + jj;
            ((float*)(F.ws + WS_MOD))[(size_t)(l * 5 + mb) * 6 * D + jc] = s + F.in[I_BMOD][l * 6 * D + jc]; }
        __syncthreads();
    }
}

__device__ __forceinline__ void transpose_item(const float* W, int ldw, int k0, int srccol, bf16* WT, int Kt, int kdst0, int nrow0, LAS float* scr, int lane) {
    float tv[32];
#pragma unroll
    for (int i = 0; i < 32; ++i) { const int kk = 2 * i + (lane >> 5); tv[i] = srccol >= 0 ? W[(size_t)(k0 + kk) * ldw + srccol] : 0.f; }
#pragma unroll
    for (int i = 0; i < 32; ++i) { const int kk = 2 * i + (lane >> 5); scr[kk * 33 + (lane & 31)] = tv[i]; }
    LDS_WAIT(); asm volatile("" ::: "memory");
    const int c = lane & 7;
#pragma unroll
    for (int j = 0; j < 4; ++j) { const int n = (lane >> 3) + 8 * j; const LAS float* s = scr + (8 * c) * 33 + n;
        u32x4 o; o.x = pk2(s[0 * 33], s[1 * 33]); o.y = pk2(s[2 * 33], s[3 * 33]); o.z = pk2(s[4 * 33], s[5 * 33]); o.w = pk2(s[6 * 33], s[7 * 33]);
        *(u32x4*)(WT + (size_t)(nrow0 + n) * Kt + kdst0 + 8 * c) = o; }
    LDS_WAIT(); asm volatile("" ::: "memory");
}
__device__ __forceinline__ int win_src(int n) {
    if (n < 1536) return n;
    if (n < 1920) return 1552 + (n - 1536);
    if (n < 1936) return 1536 + (n - 1920);
    if (n < 2048) return -1;
    return 1936 + (n - 2048);
}
__device__ __forceinline__ void p0_weights(Frame& F, int l) {
    PHASE_IDS();
    LAS float* scr = (LAS float*)(F.lds + 32768 + wave * 8704);
    const int gw = F.vcu * NWAVES + wave, NGW = F.G * NWAVES;
    constexpr int I_IN = (ZW / 32) * (D / 64), I_UP = (D / 32) * (1920 / 64), I_OUT = (D / 32) * (D / 64), I_F1 = (FF2 / 32) * (D / 64), I_F2 = (D / 32) * (FFH / 64), I_GL = (384 / 32) * (384 / 64);
    constexpr int NITEMS = I_IN + I_UP + I_OUT + I_F1 + I_F2 + I_GL;
    const int ln = lane & 31;
    for (int it = gw; it < NITEMS; it += NGW) {
        int r = it;
        if (r < I_IN) { const int kb = r / (ZW / 32), nb = r % (ZW / 32);
            transpose_item(F.in[I_WIN] + (size_t)l * D * IN_DIM, IN_DIM, 64 * kb, win_src(32 * nb + ln), (bf16*)(F.ws + WS_WIN), D, 64 * kb, 32 * nb, scr, lane); continue; } r -= I_IN;
        if (r < I_UP) { const int kb = r / (D / 32), nb = r % (D / 32); const int kd = 64 * kb;
            const float* W; int ks;
            if (kd < 512) { W = F.in[I_WUPM] + (size_t)l * 512 * D; ks = kd; } else if (kd < 1024) { W = F.in[I_WUPSGU] + (size_t)l * 512 * D; ks = kd - 512; }
            else if (kd < 1408) { W = F.in[I_WUPS5] + (size_t)l * 384 * D; ks = kd - 1024; } else { W = F.in[I_WUPSC] + (size_t)l * 512 * D; ks = kd - 1408; }
            transpose_item(W, D, ks, 32 * nb + ln, (bf16*)(F.ws + WS_WUP), 1920, kd, 32 * nb, scr, lane); continue; } r -= I_UP;
        if (r < I_OUT) { const int kb = r / (D / 32), nb = r % (D / 32);
            transpose_item(F.in[I_WOUT] + (size_t)l * D * D, D, 64 * kb, 32 * nb + ln, (bf16*)(F.ws + WS_WOUT), D, 64 * kb, 32 * nb, scr, lane); continue; } r -= I_OUT;
        if (r < I_F1) { const int kb = r / (FF2 / 32), nb = r % (FF2 / 32); const int n0 = 32 * nb, pn = n0 >> 8, j = n0 & 255;
            const float* W = (j < 128 ? F.in[I_WFFG] : F.in[I_WFFU]) + (size_t)l * D * FFH;
            transpose_item(W, FFH, 64 * kb, 128 * pn + (j & 127) + ln, (bf16*)(F.ws + WS_WFF1), D, 64 * kb, n0, scr, lane); continue; } r -= I_F1;
        if (r < I_F2) { const int kb = r / (D / 32), nb = r % (D / 32);
            transpose_item(F.in[I_WFFD] + (size_t)l * FFH * D, D, 64 * kb, 32 * nb + ln, (bf16*)(F.ws + WS_WFF2), FFH, 64 * kb, 32 * nb, scr, lane); continue; } r -= I_F2;
        { const int kb = r / (384 / 32), nb = r % (384 / 32);
            transpose_item(F.in[I_WGLU] + (size_t)l * 384 * 384, 384, 64 * kb, 32 * nb + ln, (bf16*)(F.ws + WS_WGLU), 384, 64 * kb, 32 * nb, scr, lane); }
    }
}

__device__ __forceinline__ void norm_phase(Frame& F, const float* xl, const float* xc, const float* gn, int l, int si, int nrows) {
    PHASE_IDS();
    const int gw = F.vcu * NWAVES + wave, NGW = F.G * NWAVES;
    bf16* hn = (bf16*)(F.ws + WS_HN);
    const f32x4* g4 = (const f32x4*)gn + lane;
    for (int R0 = gw; R0 < nrows; R0 += 4 * NGW) {
        f32x4 v[4][4];
#pragma unroll
        for (int q = 0; q < 4; ++q) { const int R = R0 + q * NGW; if (R < nrows) { const float* xrow = R < MLAT ? xl + (size_t)R * D : xc + (size_t)(R - MLAT) * D; const f32x4* xr = (const f32x4*)xrow + lane;
#pragma unroll
                for (int j = 0; j < 4; ++j) v[q][j] = xr[64 * j]; } }
#pragma unroll
        for (int q = 0; q < 4; ++q) { const int R = R0 + q * NGW; if (R < nrows) {
            const int mb = R < MLAT ? R / SEQ : 4; float ss = 0.f;
#pragma unroll
            for (int j = 0; j < 4; ++j) ss += (v[q][j].x * v[q][j].x + v[q][j].y * v[q][j].y) + (v[q][j].z * v[q][j].z + v[q][j].w * v[q][j].w);
            const float rstd = __builtin_amdgcn_rsqf(wave_sum(ss) * (1.f / D) + RMS_EPS);
            const f32x4* sh = (const f32x4*)modp(F, l, mb, si) + lane; const f32x4* sc = (const f32x4*)modp(F, l, mb, si + 1) + lane;
            unsigned long long* o8 = (unsigned long long*)(hn + (size_t)R * D) + lane;
#pragma unroll
            for (int j = 0; j < 4; ++j) { const f32x4 g = g4[64 * j], s_ = sc[64 * j], h = sh[64 * j];
                const f32x4 y = v[q][j] * rstd * g * (s_ + 1.0f) + h;
                o8[64 * j] = (unsigned long long)pk2(y.x, y.y) | ((unsigned long long)pk2(y.z, y.w) << 32); } } }
    }
}
__device__ __forceinline__ void final_norm_phase(Frame& F) {
    PHASE_IDS();
    const int gw = F.vcu * NWAVES + wave, NGW = F.G * NWAVES;
    const f32x4* g4 = (const f32x4*)F.in[I_GFINAL] + lane;
    for (int R0 = gw; R0 < MLAT; R0 += 4 * NGW) {
        f32x4 v[4][4];
#pragma unroll
        for (int q = 0; q < 4; ++q) { const int R = R0 + q * NGW; if (R < MLAT) { const f32x4* xr = (const f32x4*)(F.out + (size_t)R * D) + lane;
#pragma unroll
                for (int j = 0; j < 4; ++j) v[q][j] = xr[64 * j]; } }
#pragma unroll
        for (int q = 0; q < 4; ++q) { const int R = R0 + q * NGW; if (R < MLAT) { float ss = 0.f;
#pragma unroll
            for (int j = 0; j < 4; ++j) ss += (v[q][j].x * v[q][j].x + v[q][j].y * v[q][j].y) + (v[q][j].z * v[q][j].z + v[q][j].w * v[q][j].w);
            const float rstd = __builtin_amdgcn_rsqf(wave_sum(ss) * (1.f / D) + RMS_EPS);
            f32x4* xr = (f32x4*)(F.out + (size_t)R * D) + lane;
#pragma unroll
            for (int j = 0; j < 4; ++j) xr[64 * j] = v[q][j] * rstd * g4[64 * j]; } }
    }
}

struct EpiResid {
    static constexpr bool PERM = false;
    const float* base_l; const float* base_c; float* out_l; float* out_c; const float* mod;
    __device__ __forceinline__ void operator()(const f32x4 (&acc)[2][2][4][2], const pg8::Unit& u, int wr, int wc, int fr, int fq) const {
        const int pmg = u.pmg; const bool isc = pmg >= 64;
        const float* base = isc ? base_c + (size_t)(pmg - 64) * 256 * D : base_l + (size_t)pmg * 256 * D;
        float* out = isc ? out_c + (size_t)(pmg - 64) * 256 * D : out_l + (size_t)pmg * 256 * D;
        const float* mv = mod + (size_t)mb_of_tile(pmg) * 6 * D;
        const int row0 = wr * 64 + fr, col0 = u.pn * 256 + wc * 32 + 4 * fq;
#pragma unroll
        for (int ai = 0; ai < 2; ++ai)
#pragma unroll
            for (int m = 0; m < 4; ++m) { const size_t off = (size_t)(row0 + ai * 128 + m * 16) * D + col0;
#pragma unroll
                for (int bj = 0; bj < 2; ++bj)
#pragma unroll
                    for (int n = 0; n < 2; ++n) { const f32x4 b = *(const f32x4*)(base + off + bj * 128 + n * 16); const f32x4 mvv = *(const f32x4*)(mv + col0 + bj * 128 + n * 16);
                        *(f32x4*)(out + off + bj * 128 + n * 16) = b + mvv * acc[ai][bj][m][n]; }
                asm volatile("" ::: "memory"); }
    }
};
struct EpiSwiglu {
    static constexpr bool PERM = true;
    bf16* H;
    __device__ __forceinline__ void operator()(const f32x4 (&acc)[2][2][4][2], const pg8::Unit& u, int wr, int wc, int fr, int fq) const {
        const int row0 = u.pmg * 256 + wr * 64 + fr, col0 = u.pn * 128 + wc * 32 + 8 * fq;
#pragma unroll
        for (int ai = 0; ai < 2; ++ai)
#pragma unroll
            for (int m = 0; m < 4; ++m) { bf16* p = H + (size_t)(row0 + ai * 128 + m * 16) * FFH + col0;
                const f32x4 g0 = acc[ai][0][m][0], g1 = acc[ai][0][m][1], u0 = acc[ai][1][m][0], u1 = acc[ai][1][m][1];
                u32x4 w; w.x = pk2(siluf_(g0[0]) * u0[0], siluf_(g0[1]) * u0[1]); w.y = pk2(siluf_(g0[2]) * u0[2], siluf_(g0[3]) * u0[3]);
                w.z = pk2(siluf_(g1[0]) * u1[0], siluf_(g1[1]) * u1[1]); w.w = pk2(siluf_(g1[2]) * u1[2], siluf_(g1[3]) * u1[3]);
                *(u32x4*)p = w; }
    }
};
struct OrderGlobal {
    const char* A; const char* B; int lda, ldb, nM, nN, nt, G, c;
    __device__ __forceinline__ bool next(int i, pg8::Unit& u) const {
        const int L = i * G + c; if (L >= nM * nN) return false;
        int pm, pn; pg8::tile_of(L, nM, nN, pm, pn);
        u.pm = pm; u.pn = pn; u.pmg = pm; u.br = 0; u.nt = nt;
        u.A = A + (size_t)pm * 256 * lda * 2; u.B = B + (size_t)pn * 256 * ldb * 2; return true;
    }
};


constexpr int ZC_Q = 0, ZC_K = 512, ZC_V = 1024, ZC_U = 1536, ZC_G = 1920, ZC_O = 2048, ZC_SU = 2560, ZC_SV = 3072, ZC_CB = 3584, ZC_CC = 4096, ZC_CX = 4608, ZC_BG = 5120;
constexpr int LDT = 136;
constexpr int NLC = 68;
constexpr size_t MS_NST = 0, MS_SC = 512 * 1024, MS_S5X = 1 * MiB;
constexpr size_t S5T_AB = 0, S5T_BB = 73728, S5T_CC = S5T_BB + 2 * 24 * 8 * 64 * 16;
__device__ __forceinline__ float geluf_(float x) { const float z = 1.5957691216f * (x + 0.044715f * x * x * x); return x * rcpf_(1.0f + __expf(-z)); }
__device__ __forceinline__ float logsigf_(float f) { return fminf(f, 0.f) - log1pf(__expf(-fabsf(f))); }
__device__ __forceinline__ int gtile_of(int g, int pm_l) { return pm_l < 32 ? g * 32 + pm_l : 64 + g * 2 + (pm_l - 32); }
__device__ __forceinline__ float bflo(unsigned w) { return __builtin_bit_cast(float, w << 16); }
__device__ __forceinline__ float bfhi(unsigned w) { return __builtin_bit_cast(float, w & 0xffff0000u); }
__device__ __forceinline__ int chain_lc(int b, int dir, int k) { return k < 2 ? 64 + 2 * b + (dir ? 1 - k : k) : 32 * b + (dir ? 31 - (k - 2) : (k - 2)); }

template <int NT, int KS>
__device__ __forceinline__ void mm_lds(f32x4 (&acc)[NT], const LAS bf16* A, int lda, const LAS bf16* BT, int ldb, int bclamp, int lane) {
    const int r = lane & 15, kq = lane >> 4;
#pragma unroll
    for (int ks = 0; ks < KS; ++ks) {
        const bf16x8 a = *(const LAS bf16x8*)(A + r * lda + ks * 32 + kq * 8);
#pragma unroll
        for (int n = 0; n < NT; ++n) { int br = n * 16 + r; br = br > bclamp ? bclamp : br;
            const bf16x8 b = *(const LAS bf16x8*)(BT + br * ldb + ks * 32 + kq * 8);
            acc[n] = __builtin_amdgcn_mfma_f32_16x16x32_bf16(a, b, acc[n], 0, 0, 0); }
    }
}
typedef short v4i16_t __attribute__((ext_vector_type(4)));
__device__ __forceinline__ bf16x8 frag_tr(const LAS bf16* T, int ld, int k0, int n0, int lane) {
    const int g = lane >> 4, q = (lane & 15) >> 2, p = lane & 3;
    const LAS bf16* a = T + (k0 + 8 * g + q) * ld + n0 + 4 * p;
    const v4i16_t lo = __builtin_amdgcn_ds_read_tr16_b64_v4i16((LAS v4i16_t*)a);
    const v4i16_t hi = __builtin_amdgcn_ds_read_tr16_b64_v4i16((LAS v4i16_t*)(a + 4 * ld));
    return (bf16x8){lo[0], lo[1], lo[2], lo[3], hi[0], hi[1], hi[2], hi[3]};
}
template <int NT, int KS>
__device__ __forceinline__ void mm_nn(f32x4 (&acc)[NT], const LAS bf16* A, int lda, const LAS bf16* B, int ldb, int lane) {
    const int r = lane & 15, kq = lane >> 4;
#pragma unroll
    for (int ks = 0; ks < KS; ++ks) {
        const bf16x8 a = *(const LAS bf16x8*)(A + r * lda + ks * 32 + kq * 8);
#pragma unroll
        for (int n = 0; n < NT; ++n) acc[n] = __builtin_amdgcn_mfma_f32_16x16x32_bf16(a, frag_tr(B, ldb, ks * 32, n * 16, lane), acc[n], 0, 0, 0);
    }
}
__device__ __forceinline__ void scan_max2(float a, float b, int lane, float& m0, float& m1) {
    float s = fmaxf(a, b);
#pragma unroll
    for (int o = 1; o < 64; o <<= 1) { const float t = __shfl_up(s, o); if (lane >= o) s = fmaxf(s, t); }
    float ex = __shfl_up(s, 1); if (lane == 0) ex = -INFINITY;
    m0 = fmaxf(ex, a); m1 = s;
}
__device__ __forceinline__ float grp16_max(float v) { v = fmaxf(v, __shfl_xor(v, 1)); v = fmaxf(v, __shfl_xor(v, 2)); v = fmaxf(v, __shfl_xor(v, 4)); v = fmaxf(v, __shfl_xor(v, 8)); return v; }
__device__ __forceinline__ float grp16_sum(float v) { v += __shfl_xor(v, 1); v += __shfl_xor(v, 2); v += __shfl_xor(v, 4); v += __shfl_xor(v, 8); return v; }

__device__ __forceinline__ void mlstm_gates(Frame& F, int l, const bf16* zx, int lc, int h, int d, int p, float& lf, float& ip) {
    const bf16* row = zx + (size_t)(lc * 128 + p) * ZW + ZC_G; const float* bg = F.in[I_BGATES] + l * 16;
    ip = bf2f(row[(2 * d) * 4 + h]) + bg[(2 * d) * 4 + h];
    lf = logsigf_(bf2f(row[(2 * d + 1) * 4 + h]) + bg[(2 * d + 1) * 4 + h]);
}
__device__ __forceinline__ float mlstm_scan128(LAS float* cum, int d, int lane, float& c0, float& c1, int& i0, int& i1) {
    i0 = d ? 127 - 2 * lane : 2 * lane; i1 = d ? 126 - 2 * lane : 2 * lane + 1;
    const float a = cum[i0], b = cum[i1]; float s = a + b;
#pragma unroll
    for (int o = 1; o < 64; o <<= 1) { const float t = __shfl_up(s, o); if (lane >= o) s += t; }
    c1 = s; c0 = s - b; cum[i0] = c0; cum[i1] = c1;
    return __shfl(s, 63);
}
__device__ __forceinline__ void qk_conv2(const bf16* zx, const float* wc  , int lr, int col, bool hl, bool hr, float& y0, float& y1) {
    const unsigned c = *(const unsigned*)(zx + (size_t)lr * ZW + col);
    const unsigned a = hl ? *(const unsigned*)(zx + (size_t)(lr - 1) * ZW + col) : 0u;
    const unsigned b = hr ? *(const unsigned*)(zx + (size_t)(lr + 1) * ZW + col) : 0u;
    const int ch = col & 511;
    y0 = siluf_(wc[ch] * bflo(a) + wc[512 + ch] * bflo(c) + wc[1024 + ch] * bflo(b));
    y1 = siluf_(wc[ch + 1] * bfhi(a) + wc[512 + ch + 1] * bfhi(c) + wc[1024 + ch + 1] * bfhi(b));
}
__device__ __forceinline__ void nbr_flags(int lc, int s, bool& hl, bool& hr) {
    if (lc < 64) { hl = (s & 63) != 0; hr = (s & 63) != 63; } else { const int t = ((lc - 64) & 1) * 128 + s; hl = t != 0; hr = t != 255; }
}

__device__ __forceinline__ void qk_conv8(const u32x4 a, const u32x4 c, const u32x4 b, const float* w  , float scale, u32x4& o) {
    float y[8];
#pragma unroll
    for (int e = 0; e < 4; ++e) {
        y[2 * e] = siluf_(w[2 * e] * bflo(a[e]) + w[8 + 2 * e] * bflo(c[e]) + w[16 + 2 * e] * bflo(b[e])) * scale;
        y[2 * e + 1] = siluf_(w[2 * e + 1] * bfhi(a[e]) + w[8 + 2 * e + 1] * bfhi(c[e]) + w[16 + 2 * e + 1] * bfhi(b[e])) * scale; }
    o = (u32x4){pk2(y[0], y[1]), pk2(y[2], y[3]), pk2(y[4], y[5]), pk2(y[6], y[7])};
}
__device__ __forceinline__ void qk_conv_rows(const bf16* zx, const float* wc, int lc, int rg, int colb, int ch0, float scale, u32x4 (&out)[4]) {
    float w[24];
#pragma unroll
    for (int j = 0; j < 3; ++j) { const f32x4 w0 = *(const f32x4*)(wc + j * 512 + ch0), w1 = *(const f32x4*)(wc + j * 512 + ch0 + 4);
#pragma unroll
        for (int e = 0; e < 4; ++e) { w[j * 8 + e] = w0[e]; w[j * 8 + 4 + e] = w1[e]; } }
    const int s0 = 4 * rg; bool hl, hr, d0, d1; nbr_flags(lc, s0, hl, d0); nbr_flags(lc, s0 + 3, d1, hr);
    const bf16* p = zx + (size_t)(lc * 128 + s0) * ZW + colb + ch0;
    u32x4 r[6];
    const u32x4 zz = zero4();
    r[0] = hl ? *(const u32x4*)(p - ZW) : zz;
#pragma unroll
    for (int i = 0; i < 4; ++i) r[1 + i] = *(const u32x4*)(p + (size_t)i * ZW);
    r[5] = hr ? *(const u32x4*)(p + (size_t)4 * ZW) : zz;
#pragma unroll
    for (int i = 0; i < 4; ++i) qk_conv8(r[i], r[i + 1], r[i + 2], w, scale, out[i]);
}
__device__ __forceinline__ void mlstm_local_item(Frame& F, int l, int lc, int h) {
    PHASE_IDS();
    bf16* zx = (bf16*)(F.ws + WS_ZX);
    LAS bf16* KP = (LAS bf16*)F.lds; LAS bf16* VF = KP + 128 * LDT; LAS bf16* VB = VF + 128 * LDT;
    LAS float* lfc = (LAS float*)(F.lds + 104448); LAS float* ipa = lfc + 256; LAS float* wa = ipa + 256;
    LAS bf16* wh = (LAS bf16*)(wa + 256);
    float* SCb = (float*)(F.ws + WS_MISC + MS_SC);
    __syncthreads();
    if (tid < 256) { const int d = tid >> 7, p = tid & 127; float lf, ip; mlstm_gates(F, l, zx, lc, h, d, p, lf, ip); lfc[tid] = lf; ipa[tid] = ip; }
    __syncthreads();
    if (wave < 2) { const int d = wave;
        float c0, c1; int i0, i1; const float tot = mlstm_scan128(lfc + d * 128, d, lane, c0, c1, i0, i1);
        const float l0 = tot - c0 + ipa[d * 128 + i0], l1 = tot - c1 + ipa[d * 128 + i1];
        float m = fmaxf(l0, l1);
#pragma unroll
        for (int o = 1; o < 64; o <<= 1) m = fmaxf(m, __shfl_xor(m, o));
        const float w0 = __expf(l0 - m), w1 = __expf(l1 - m);
        wa[d * 128 + i0] = w0; wa[d * 128 + i1] = w1; wh[d * 128 + i0] = (bf16)f2bf(w0); wh[d * 128 + i1] = (bf16)f2bf(w1);
        if (lane == 0) { float* SC = SCb + ((lc * 4 + h) * 2 + d) * 4; SC[0] = m; SC[1] = tot; }
    }
    const int rg = tid >> 4, ch0 = (tid & 15) * 8;
    const float* wcq = F.in[I_WCONVQK] + (size_t)(l * 2) * 3 * 512 + h * 128; const float* wck = wcq + 3 * 512;
    u32x4 qo[4], ko[4], vv[4];
    qk_conv_rows(zx, wcq, lc, rg, ZC_Q + h * 128, ch0, 1.0f, qo);
    qk_conv_rows(zx, wck, lc, rg, ZC_K + h * 128, ch0, 0.08838834764831845f, ko);
#pragma unroll
    for (int i = 0; i < 4; ++i) vv[i] = *(const u32x4*)(zx + (size_t)(lc * 128 + 4 * rg + i) * ZW + ZC_V + h * 128 + ch0);
    __syncthreads();
#pragma unroll
    for (int i = 0; i < 4; ++i) { const int s = 4 * rg + i;
        *(LAS u32x4*)(KP + s * LDT + ch0) = ko[i];
        const float wf = wa[s], wb = wa[128 + s]; u32x4 f, b;
#pragma unroll
        for (int e = 0; e < 4; ++e) { const float lo = bflo(vv[i][e]), hi = bfhi(vv[i][e]); f[e] = pk2(lo * wf, hi * wf); b[e] = pk2(lo * wb, hi * wb); }
        *(LAS u32x4*)(VF + s * LDT + ch0) = f; *(LAS u32x4*)(VB + s * LDT + ch0) = b;
        if (lc < 64) { bf16* zr = zx + (size_t)(lc * 128 + s) * ZW + h * 128 + ch0; *(u32x4*)(zr + ZC_Q) = qo[i]; *(u32x4*)(zr + ZC_K) = ko[i]; } }
    __syncthreads();
    f32x4 accf[9], accb[9];
#pragma unroll
    for (int n = 0; n < 9; ++n) { accf[n] = (f32x4){0.f, 0.f, 0.f, 0.f}; accb[n] = (f32x4){0.f, 0.f, 0.f, 0.f}; }
#pragma unroll
    for (int ks = 0; ks < 4; ++ks) {
        const bf16x8 a = frag_tr(KP, LDT, ks * 32, wave * 16, lane);
        const bf16x8 wfv = *(const LAS bf16x8*)(wh + ks * 32 + (lane >> 4) * 8), wbv = *(const LAS bf16x8*)(wh + 128 + ks * 32 + (lane >> 4) * 8);
#pragma unroll
        for (int n = 0; n < 8; ++n) { accf[n] = __builtin_amdgcn_mfma_f32_16x16x32_bf16(a, frag_tr(VF, LDT, ks * 32, n * 16, lane), accf[n], 0, 0, 0);
            accb[n] = __builtin_amdgcn_mfma_f32_16x16x32_bf16(a, frag_tr(VB, LDT, ks * 32, n * 16, lane), accb[n], 0, 0, 0); }
        accf[8] = __builtin_amdgcn_mfma_f32_16x16x32_bf16(a, wfv, accf[8], 0, 0, 0); accb[8] = __builtin_amdgcn_mfma_f32_16x16x32_bf16(a, wbv, accb[8], 0, 0, 0);
    }
    const int r0 = wave * 16 + (lane >> 4) * 4, cc = lane & 15;
#pragma unroll
    for (int d = 0; d < 2; ++d) { const int it = (lc * 4 + h) * 2 + d;
        bf16* MST = (bf16*)(F.ws + WS_MST) + (size_t)it * 16384; float* NST = (float*)(F.ws + WS_MISC + MS_NST) + it * 128;
#pragma unroll
        for (int n = 0; n < 8; ++n)
#pragma unroll
            for (int i = 0; i < 4; ++i) MST[(r0 + i) * 128 + n * 16 + cc] = (bf16)f2bf(d ? accb[n][i] : accf[n][i]);
        if (cc == 0) {
#pragma unroll
            for (int i = 0; i < 4; ++i) NST[r0 + i] = d ? accb[8][i] : accf[8][i]; } }
}

__device__ __forceinline__ void cmul(float& xr, float& xi, float ar, float ai) { const float r = ar * xr - ai * xi, i = ar * xi + ai * xr; xr = r; xi = i; }
__device__ __forceinline__ void s5_tables(Frame& F, int l) {
    PHASE_IDS();
    unsigned char* T = F.ws + WS_S5T;
    for (int idx = F.vcu * NTHR + tid; idx < 2 * 24 * 64; idx += F.G * NTHR) {
        const int dir = idx / 1536, g5 = (idx % 1536) >> 6, p = idx & 63;
        const int ix = ((l * 2 + dir) * 24 + g5) * 64 + p;
        const float are = F.in[I_S5ARE][ix], aim = F.in[I_S5AIM][ix];
        const float dt = __expf(F.in[I_S5LOGDT][(l * 2 + dir) * 24 + g5]);
        const float mag = __expf(dt * are); float rev = dt * aim * 0.15915494309189535f; rev -= floorf(rev);
        const float ab_re = mag * __builtin_amdgcn_cosf(rev), ab_im = mag * __builtin_amdgcn_sinf(rev);
        float pr = ab_re, pi = ab_im;
#pragma unroll
        for (int q = 0; q < 5; ++q) { const float r = pr * pr - pi * pi, i = 2.f * pr * pi; pr = r; pi = i; }
        const float a32r = pr, a32i = pi;
#pragma unroll
        for (int q = 0; q < 2; ++q) { const float r = pr * pr - pi * pi, i = 2.f * pr * pi; pr = r; pi = i; }
        float* ab = (float*)(T + S5T_AB) + (size_t)idx * 6;
        ab[0] = ab_re; ab[1] = ab_im; ab[2] = a32r; ab[3] = a32i; ab[4] = pr; ab[5] = pi;
        const float nr = ab_re - 1.0f, ni = ab_im, den = rcpf_(are * are + aim * aim);
        const float f_re = (nr * are + ni * aim) * den, f_im = (ni * are - nr * aim) * den;
        const f32x4* br = (const f32x4*)(F.in[I_S5BRE] + ((size_t)(l * 24 + g5) * 64 + p) * 16); const f32x4* bi = (const f32x4*)(F.in[I_S5BIM] + ((size_t)(l * 24 + g5) * 64 + p) * 16);
        float bbr[16], bbi[16];
#pragma unroll
        for (int q = 0; q < 4; ++q) { const f32x4 r = br[q], i = bi[q];
#pragma unroll
            for (int e = 0; e < 4; ++e) { bbr[q * 4 + e] = f_re * r[e] - f_im * i[e]; bbi[q * 4 + e] = f_re * i[e] + f_im * r[e]; } }
        u32x4* bb = (u32x4*)(T + S5T_BB) + (size_t)(dir * 24 + g5) * 8 * 64;
        const int pt = p >> 3, cc = (2 * p) & 15;
#pragma unroll
        for (int g = 0; g < 4; ++g) {
            u32x4 vr = (u32x4){0u, 0u, 0u, 0u}, vi = vr;
            if (g < 2) { vr = (u32x4){pk2(bbr[8 * g], bbr[8 * g + 1]), pk2(bbr[8 * g + 2], bbr[8 * g + 3]), pk2(bbr[8 * g + 4], bbr[8 * g + 5]), pk2(bbr[8 * g + 6], bbr[8 * g + 7])};
                         vi = (u32x4){pk2(bbi[8 * g], bbi[8 * g + 1]), pk2(bbi[8 * g + 2], bbi[8 * g + 3]), pk2(bbi[8 * g + 4], bbi[8 * g + 5]), pk2(bbi[8 * g + 6], bbi[8 * g + 7])}; }
            bb[pt * 64 + g * 16 + cc] = vr; bb[pt * 64 + g * 16 + cc + 1] = vi; }
    }
    for (int idx = F.vcu * NTHR + tid; idx < 24 * 4 * 64; idx += F.G * NTHR) {
        const int g5 = idx >> 8, ks = (idx >> 6) & 3, ln = idx & 63, j = ln & 15, k = ks * 32 + (ln >> 4) * 8, p0 = k >> 1;
        const f32x4 cr = *(const f32x4*)(F.in[I_S5CRE] + ((size_t)(l * 24 + g5) * 16 + j) * 64 + p0), ci = *(const f32x4*)(F.in[I_S5CIM] + ((size_t)(l * 24 + g5) * 16 + j) * 64 + p0);
        ((u32x4*)(T + S5T_CC))[idx] = (u32x4){pk2(cr[0], -ci[0]), pk2(cr[1], -ci[1]), pk2(cr[2], -ci[2]), pk2(cr[3], -ci[3])};
    }
}
__device__ __forceinline__ void s5_drive32(const u32x4* bbf  , const LAS bf16* U16, LAS bf16* BU, int lane) {
    const bf16x8 b0 = *(const LAS bf16x8*)(U16 + (lane & 15) * 32 + (lane >> 4) * 8), b1 = *(const LAS bf16x8*)(U16 + (16 + (lane & 15)) * 32 + (lane >> 4) * 8);
#pragma unroll
    for (int pt = 0; pt < 8; ++pt) {
        const bf16x8 a = __builtin_bit_cast(bf16x8, bbf[pt * 64 + lane]);
        const f32x4 z = (f32x4){0.f, 0.f, 0.f, 0.f};
        const f32x4 o0 = __builtin_amdgcn_mfma_f32_16x16x32_bf16(a, b0, z, 0, 0, 0), o1 = __builtin_amdgcn_mfma_f32_16x16x32_bf16(a, b1, z, 0, 0, 0);
        *(LAS u32x2*)(BU + (lane & 15) * LDT + pt * 16 + (lane >> 4) * 4) = (u32x2){pk2(o0[0], o0[1]), pk2(o0[2], o0[3])};
        *(LAS u32x2*)(BU + (16 + (lane & 15)) * LDT + pt * 16 + (lane >> 4) * 4) = (u32x2){pk2(o1[0], o1[1]), pk2(o1[2], o1[3])};
    }
}
__device__ __forceinline__ void s5_local_item(Frame& F, int l, int lc, int sub) {
    PHASE_IDS();
    const bf16* zx = (const bf16*)(F.ws + WS_ZX);
    const int wt = sub * 8 + wave, g5 = wt >> 1, dir = wt & 1, p = lane;
    LAS bf16* U16 = (LAS bf16*)(F.lds + wave * 16896); LAS bf16* BU = U16 + 128 * 32;
    __syncthreads();
    const float* abp = (const float*)(F.ws + WS_S5T + S5T_AB) + (size_t)((dir * 24 + g5) * 64 + p) * 6;
    const float ab_re = abp[0], ab_im = abp[1];
    const u32x4* bbf = (const u32x4*)(F.ws + WS_S5T + S5T_BB) + (size_t)(dir * 24 + g5) * 8 * 64;
#pragma unroll
    for (int i = 0; i < 4; ++i) { const int c = i * 64 + lane, t = c >> 1, h8 = (c & 1) * 8;
        *(LAS u32x4*)(U16 + t * 32 + h8) = *(const u32x4*)(zx + (size_t)(lc * 128 + t) * ZW + ZC_U + g5 * 16 + h8);
        *(LAS u32x4*)(U16 + t * 32 + 16 + h8) = zero4(); }
    LDS_WAIT(); asm volatile("" ::: "memory");
    float xr = 0.f, xi = 0.f;
    f32x2* E = (f32x2*)(F.ws + WS_S5E);
#pragma unroll 1
    for (int qq = 0; qq < 4; ++qq) {
        const int q = dir ? 3 - qq : qq;
        s5_drive32(bbf, U16 + q * 32 * 32, BU, lane);
        LDS_WAIT(); asm volatile("" ::: "memory");
#pragma unroll 8
        for (int k = 0; k < 32; ++k) { const int tl = dir ? 31 - k : k;
            const unsigned w2 = *(const LAS unsigned*)(BU + tl * LDT + 2 * p); const float bur = bflo(w2), bui = bfhi(w2);
            const float nr = ab_re * xr - ab_im * xi + bur, ni = ab_re * xi + ab_im * xr + bui; xr = nr; xi = ni; }
        E[((size_t)((lc * 2 + dir) * 4 + qq) * 24 + g5) * 64 + p] = (f32x2){xr, xi};
        LDS_WAIT(); asm volatile("" ::: "memory");
    }
}

__device__ __forceinline__ void scan_phase(Frame& F, int l) {
    PHASE_IDS();
    float* SCb = (float*)(F.ws + WS_MISC + MS_SC);
    for (int w = F.vcu; w < 256; w += F.G) {
        const int chain = w >> 4, blk = w & 15, b = chain >> 3, h = (chain >> 1) & 3, d = chain & 1;
        bf16* MSTb = (bf16*)(F.ws + WS_MST) + blk * 1024 + tid * 2;
        f32x2 v[34], sv[34];
#pragma unroll
        for (int k = 0; k < 34; ++k) { const int it = (chain_lc(b, d, k) * 4 + h) * 2 + d; const unsigned w2 = *(const unsigned*)(MSTb + (size_t)it * 16384); v[k] = (f32x2){bflo(w2), bfhi(w2)}; sv[k] = *(const f32x2*)(SCb + it * 4); }
        float zf = 0.f; asm volatile("" : "+v"(zf));
        float m = 0.f; f32x2 carry = (f32x2){zf, zf};
#pragma unroll
        for (int k = 0; k < 34; ++k) { const int it = (chain_lc(b, d, k) * 4 + h) * 2 + d;
            const float ml = sv[k].x, bl = sv[k].y, mn = fmaxf(bl + m, ml), dec = __expf(bl + m - mn), sc = __expf(ml - mn);
            *(unsigned*)(MSTb + (size_t)it * 16384) = pk2(carry.x, carry.y); carry = carry * dec + v[k] * sc;
            if (blk == 0 && tid == 0) SCb[it * 4 + 2] = m;
            m = mn; }
        if (blk == 1 && tid < 128) {
            float* NSTb = (float*)(F.ws + WS_MISC + MS_NST) + tid; float nv[34]; f32x2 sn[34];
#pragma unroll
            for (int k = 0; k < 34; ++k) { const int it = (chain_lc(b, d, k) * 4 + h) * 2 + d; nv[k] = NSTb[it * 128]; sn[k] = *(const f32x2*)(SCb + it * 4); }
            float mm = 0.f, cn = 0.f; asm volatile("" : "+v"(cn));
#pragma unroll
            for (int k = 0; k < 34; ++k) { const int it = (chain_lc(b, d, k) * 4 + h) * 2 + d;
                const float ml = sn[k].x, bl = sn[k].y, mn = fmaxf(bl + mm, ml), dec = __expf(bl + mm - mn), sc = __expf(ml - mn);
                NSTb[it * 128] = cn; cn = cn * dec + nv[k] * sc; mm = mn; }
        }
    }
    for (int w = F.vcu; w < 12; w += F.G) {
        const int gid = w * 512 + tid, b = gid / 3072, rem = gid % 3072, dir = rem / 1536, g5 = (rem % 1536) >> 6, p = rem & 63;
        const float* abp = (const float*)(F.ws + WS_S5T + S5T_AB) + (size_t)((dir * 24 + g5) * 64 + p) * 6; const float ar = abp[4], ai = abp[5];
        const f32x2* E = (const f32x2*)(F.ws + WS_S5E); f32x2* X = (f32x2*)(F.ws + WS_MISC + MS_S5X);
        f32x2 e[34];
#pragma unroll
        for (int k = 0; k < 34; ++k) { const int lc = chain_lc(b, dir, k); e[k] = E[((size_t)((lc * 2 + dir) * 4 + 3) * 24 + g5) * 64 + p]; }
        float xr = 0.f; asm volatile("" : "+v"(xr)); float xi = xr;
#pragma unroll
        for (int k = 0; k < 34; ++k) { const int lc = chain_lc(b, dir, k); X[((size_t)(lc * 2 + dir) * 24 + g5) * 64 + p] = (f32x2){xr, xi};
            cmul(xr, xi, ar, ai); xr += e[k].x; xi += e[k].y; }
    }
}

__device__ __forceinline__ void mlstm_out_item(Frame& F, int l, int lc, int h) {
    PHASE_IDS();
    bf16* zx = (bf16*)(F.ws + WS_ZX);
    LAS bf16* Q = (LAS bf16*)F.lds; LAS bf16* KS = Q + 128 * LDT; LAS bf16* V = KS + 128 * LDT; LAS bf16* C = V + 128 * LDT;
    LAS float* gs = (LAS float*)(F.lds + 139264); LAS float* mm = gs + 256; LAS float* mt = mm + 256;
    LAS bf16* nv = (LAS bf16*)(mt + 256);
    const float* SCb = (const float*)(F.ws + WS_MISC + MS_SC);
    __syncthreads();
    if (tid < 256) { const int d = tid >> 7, p = tid & 127; float lf, ip; mlstm_gates(F, l, zx, lc, h, d, p, lf, ip); gs[tid] = lf; mm[tid] = ip; }
    { const int rg = tid >> 4, ch0 = (tid & 15) * 8; u32x4 qo[4], ko[4], vv[4];
        if (lc < 64) {
#pragma unroll
            for (int i = 0; i < 4; ++i) { const bf16* zr = zx + (size_t)(lc * 128 + 4 * rg + i) * ZW + h * 128 + ch0; qo[i] = *(const u32x4*)(zr + ZC_Q); ko[i] = *(const u32x4*)(zr + ZC_K); }
        } else {
            const float* wcq = F.in[I_WCONVQK] + (size_t)(l * 2) * 3 * 512 + h * 128; const float* wck = wcq + 3 * 512;
            qk_conv_rows(zx, wcq, lc, rg, ZC_Q + h * 128, ch0, 1.0f, qo); qk_conv_rows(zx, wck, lc, rg, ZC_K + h * 128, ch0, 0.08838834764831845f, ko);
        }
#pragma unroll
        for (int i = 0; i < 4; ++i) vv[i] = *(const u32x4*)(zx + (size_t)(lc * 128 + 4 * rg + i) * ZW + ZC_V + h * 128 + ch0);
#pragma unroll
        for (int i = 0; i < 4; ++i) { const int s_ = 4 * rg + i; *(LAS u32x4*)(Q + s_ * LDT + ch0) = qo[i]; *(LAS u32x4*)(KS + s_ * LDT + ch0) = ko[i]; *(LAS u32x4*)(V + s_ * LDT + ch0) = vv[i]; } }
    __syncthreads();
    if (wave < 2) { const int d = wave; LAS float* gd = gs + d * 128; LAS float* md = mm + d * 128; LAS float* td = mt + d * 128;
        float c0, c1; int i0, i1; (void)mlstm_scan128(gd, d, lane, c0, c1, i0, i1);
        const float g0 = md[i0] - c0, g1 = md[i1] - c1; float p0, p1; scan_max2(g0, g1, lane, p0, p1);
        const float m_in = SCb[((lc * 4 + h) * 2 + d) * 4 + 2];
        const float mm0 = fmaxf(m_in, p0), mm1 = fmaxf(m_in, p1);
        gd[i0] = g0; gd[i1] = g1; md[i0] = mm0; md[i1] = mm1; td[i0] = c0 + mm0; td[i1] = c1 + mm1; }
    f32x4 sraw[8];
#pragma unroll
    for (int n = 0; n < 8; ++n) sraw[n] = (f32x4){0.f, 0.f, 0.f, 0.f};
    mm_lds<8, 4>(sraw, KS + (wave * 16) * LDT, LDT, Q, LDT, 127, lane);
    __syncthreads();
    f32x4 hs[8];
#pragma unroll
    for (int n = 0; n < 8; ++n) hs[n] = (f32x4){0.f, 0.f, 0.f, 0.f};
    const int r0 = wave * 16 + (lane >> 4) * 4, cc = lane & 15;
#pragma unroll 1
    for (int dir = 0; dir < 2; ++dir) {
        const int it = (lc * 4 + h) * 2 + dir;
        const float m_in = SCb[it * 4 + 2];
        {
            const bf16* MST = (const bf16*)(F.ws + WS_MST) + (size_t)it * 16384;
#pragma unroll
            for (int q = 0; q < 4; ++q) { const int idx = q * 512 + tid, dd = idx >> 4, e0 = (idx & 15) * 8;
                *(LAS u32x4*)(C + dd * LDT + e0) = *(const u32x4*)(MST + dd * 128 + e0); }
            if (tid < 128) nv[tid] = (bf16)f2bf(((const float*)(F.ws + WS_MISC + MS_NST))[it * 128 + tid]);
        }
        const LAS float* gd = gs + dir * 128; const LAS float* md = mm + dir * 128; const LAS float* td = mt + dir * 128;
        {
            float g4[4];
#pragma unroll
            for (int i = 0; i < 4; ++i) g4[i] = gd[r0 + i];
#pragma unroll
            for (int n = 0; n < 8; ++n) { const int t = n * 16 + cc; const float mmt = md[t]; float v[4];
#pragma unroll
                for (int i = 0; i < 4; ++i) { const int s_ = r0 + i; const bool ok = dir ? (s_ >= t) : (s_ <= t); v[i] = ok ? sraw[n][i] * __expf(g4[i] - mmt) : 0.f; }
                *(LAS u32x2*)(KS + t * LDT + r0) = (u32x2){pk2(v[0], v[1]), pk2(v[2], v[3])}; } }
        __syncthreads();
        f32x4 ao[8], den = (f32x4){0.f, 0.f, 0.f, 0.f};
#pragma unroll
        for (int n = 0; n < 8; ++n) ao[n] = (f32x4){0.f, 0.f, 0.f, 0.f};
        const LAS bf16* Aq = Q + (wave * 16) * LDT; const LAS bf16* As = KS + (wave * 16) * LDT;
#pragma unroll
        for (int ks = 0; ks < 4; ++ks) { const bf16x8 a = *(const LAS bf16x8*)(Aq + (lane & 15) * LDT + ks * 32 + (lane >> 4) * 8);
            den = __builtin_amdgcn_mfma_f32_16x16x32_bf16(a, *(const LAS bf16x8*)(nv + ks * 32 + (lane >> 4) * 8), den, 0, 0, 0);
#pragma unroll
            for (int n = 0; n < 8; ++n) ao[n] = __builtin_amdgcn_mfma_f32_16x16x32_bf16(a, frag_tr(C, LDT, ks * 32, n * 16, lane), ao[n], 0, 0, 0); }
        float inter[4], emt[4];
#pragma unroll
        for (int i = 0; i < 4; ++i) { inter[i] = __expf(m_in - md[r0 + i]); emt[i] = __expf(-td[r0 + i]); den[i] *= inter[i]; }
#pragma unroll
        for (int n = 0; n < 8; ++n)
#pragma unroll
            for (int i = 0; i < 4; ++i) ao[n][i] *= inter[i];
        const bf16x8 ones = (bf16x8){0x3F80, 0x3F80, 0x3F80, 0x3F80, 0x3F80, 0x3F80, 0x3F80, 0x3F80};
#pragma unroll
        for (int ks = 0; ks < 4; ++ks) { const bf16x8 a = *(const LAS bf16x8*)(As + (lane & 15) * LDT + ks * 32 + (lane >> 4) * 8);
            den = __builtin_amdgcn_mfma_f32_16x16x32_bf16(a, ones, den, 0, 0, 0);
#pragma unroll
            for (int n = 0; n < 8; ++n) ao[n] = __builtin_amdgcn_mfma_f32_16x16x32_bf16(a, frag_tr(V, LDT, ks * 32, n * 16, lane), ao[n], 0, 0, 0); }
#pragma unroll
        for (int i = 0; i < 4; ++i) { const float nr = rcpf_(fmaxf(fabsf(den[i]), emt[i]));
#pragma unroll
            for (int n = 0; n < 8; ++n) hs[n][i] += ao[n][i] * nr; }
        __syncthreads();
    }
    const float* gm = F.in[I_GMH] + l * 512 + h * 128;
#pragma unroll
    for (int i = 0; i < 4; ++i) { float ss = 0.f;
#pragma unroll
        for (int n = 0; n < 8; ++n) ss += hs[n][i] * hs[n][i];
        const float rstd = __builtin_amdgcn_rsqf(grp16_sum(ss) * (1.0f / 128.0f) + RMS_EPS);
        bf16* orow = zx + (size_t)(lc * 128 + r0 + i) * ZW + ZC_O + h * 128;
#pragma unroll
        for (int n = 0; n < 8; ++n) { const int e = n * 16 + cc; const float o = bf2f(orow[e]); orow[e] = (bf16)f2bf(hs[n][i] * rstd * gm[e] * o); } }
}

__device__ __forceinline__ void sgu_conv_item(Frame& F, int l, int lc) {
    PHASE_IDS();
    bf16* zx = (bf16*)(F.ws + WS_ZX);
    LAS bf16* W = (LAS bf16*)F.lds; LAS bf16* VN = W + 128 * LDT;
    __syncthreads();
    const int t = tid >> 2, part = tid & 3;
    u32x4 gv[16]; float mu, rs;
    { const u32x4* p = (const u32x4*)(zx + (size_t)(lc * 128 + t) * ZW + ZC_SV + part * 128);
        float s1 = 0.f, s2 = 0.f;
#pragma unroll
        for (int q = 0; q < 16; ++q) gv[q] = p[q];
#pragma unroll
        for (int q = 0; q < 16; ++q) {
#pragma unroll
            for (int e = 0; e < 4; ++e) { const float a = bflo(gv[q][e]), b = bfhi(gv[q][e]); s1 += a + b; s2 += a * a + b * b; } }
        s1 += __shfl_xor(s1, 1); s1 += __shfl_xor(s1, 2); s2 += __shfl_xor(s2, 1); s2 += __shfl_xor(s2, 2);
        mu = s1 * (1.0f / 512.0f); rs = __builtin_amdgcn_rsqf(fmaxf(s2 * (1.0f / 512.0f) - mu * mu, 0.f) + RMS_EPS); }
#pragma unroll 1
    for (int sg = 0; sg < 4; ++sg) {
        if (sg) __syncthreads();
        if (part == sg) {
#pragma unroll
            for (int q = 0; q < 16; ++q) { u32x4 o;
#pragma unroll
                for (int e = 0; e < 4; ++e) o[e] = pk2((bflo(gv[q][e]) - mu) * rs, (bfhi(gv[q][e]) - mu) * rs);
                *(LAS u32x4*)(VN + t * LDT + q * 8) = o; } }
        { const float* ws = F.in[I_WSGU] + (size_t)(l * 4 + sg) * 128 * 128;
#pragma unroll
            for (int q = 0; q < 8; ++q) { const int idx = q * 512 + tid, tt = idx >> 5, s0 = (idx & 31) * 4; const f32x4 w4 = *(const f32x4*)(ws + tt * 128 + s0);
                *(LAS u32x2*)(W + tt * LDT + s0) = (u32x2){pk2(w4[0], w4[1]), pk2(w4[2], w4[3])}; } }
        __syncthreads();
        f32x4 acc[8];
#pragma unroll
        for (int n = 0; n < 8; ++n) acc[n] = (f32x4){0.f, 0.f, 0.f, 0.f};
#pragma unroll
        for (int ks = 0; ks < 4; ++ks) { const bf16x8 a = frag_tr(VN, LDT, ks * 32, wave * 16, lane);
#pragma unroll
            for (int n = 0; n < 8; ++n) acc[n] = __builtin_amdgcn_mfma_f32_16x16x32_bf16(a, *(const LAS bf16x8*)(W + (n * 16 + (lane & 15)) * LDT + ks * 32 + (lane >> 4) * 8), acc[n], 0, 0, 0); }
        const int d0 = wave * 16 + (lane >> 4) * 4;
        const f32x4 g4 = *(const f32x4*)(F.in[I_GSGU] + l * 512 + sg * 128 + d0);
        const float* bs = F.in[I_BSGU] + (l * 4 + sg) * 128;
#pragma unroll
        for (int n = 0; n < 8; ++n) { const int tt = n * 16 + (lane & 15); const float bt = bs[tt];
            u32x2* p = (u32x2*)(zx + (size_t)(lc * 128 + tt) * ZW + ZC_SU + sg * 128 + d0); const u32x2 su = *p;
            u32x2 o; o.x = pk2(bflo(su.x) * (g4[0] * acc[n][0] + bt), bfhi(su.x) * (g4[1] * acc[n][1] + bt));
            o.y = pk2(bflo(su.y) * (g4[2] * acc[n][2] + bt), bfhi(su.y) * (g4[3] * acc[n][3] + bt));
            *p = o; }
    }
    {
        const int rg = tid >> 4, c8 = (tid & 15) * 8, s0 = 4 * rg; bool hl, hr, d0_, d1_; nbr_flags(lc, s0, hl, d0_); nbr_flags(lc, s0 + 3, d1_, hr);
#pragma unroll 1
        for (int sg = 0; sg < 4; ++sg) { const int ch = sg * 128 + c8;
            float w[24];
#pragma unroll
            for (int j = 0; j < 3; ++j) { const f32x4 w0 = *(const f32x4*)(F.in[I_WSCONV] + (size_t)(l * 3 + j) * 512 + ch), w1 = *(const f32x4*)(F.in[I_WSCONV] + (size_t)(l * 3 + j) * 512 + ch + 4);
#pragma unroll
                for (int e = 0; e < 4; ++e) { w[j * 8 + e] = w0[e]; w[j * 8 + 4 + e] = w1[e]; } }
            const bf16* pc = zx + (size_t)(lc * 128 + s0) * ZW + ZC_CC + ch; const bf16* px = zx + (size_t)(lc * 128 + s0) * ZW + ZC_CX + ch; bf16* pb = zx + (size_t)(lc * 128 + s0) * ZW + ZC_CB + ch;
            u32x4 c[6], x[6], cb[4]; const u32x4 z4 = zero4();
            c[0] = hl ? *(const u32x4*)(pc - ZW) : z4; x[0] = hl ? *(const u32x4*)(px - ZW) : z4;
#pragma unroll
            for (int i = 0; i < 4; ++i) { c[1 + i] = *(const u32x4*)(pc + (size_t)i * ZW); x[1 + i] = *(const u32x4*)(px + (size_t)i * ZW); cb[i] = *(const u32x4*)(pb + (size_t)i * ZW); }
            c[5] = hr ? *(const u32x4*)(pc + (size_t)4 * ZW) : z4; x[5] = hr ? *(const u32x4*)(px + (size_t)4 * ZW) : z4;
            float pl[6][8];
#pragma unroll
            for (int r = 0; r < 6; ++r)
#pragma unroll
                for (int e = 0; e < 4; ++e) { pl[r][2 * e] = bflo(c[r][e]) * bflo(x[r][e]); pl[r][2 * e + 1] = bfhi(c[r][e]) * bfhi(x[r][e]); }
#pragma unroll
            for (int i = 0; i < 4; ++i) { u32x4 o;
#pragma unroll
                for (int e = 0; e < 4; ++e) { const float y0 = bflo(cb[i][e]) * (w[2 * e] * pl[i][2 * e] + w[8 + 2 * e] * pl[i + 1][2 * e] + w[16 + 2 * e] * pl[i + 2][2 * e]);
                    const float y1 = bfhi(cb[i][e]) * (w[2 * e + 1] * pl[i][2 * e + 1] + w[8 + 2 * e + 1] * pl[i + 1][2 * e + 1] + w[16 + 2 * e + 1] * pl[i + 2][2 * e + 1]); o[e] = pk2(y0, y1); }
                *(u32x4*)(pb + (size_t)i * ZW) = o; } }
    }
}

__device__ __forceinline__ void s5_out_item(Frame& F, int l, int lc, int q) {
    PHASE_IDS();
    bf16* zx = (bf16*)(F.ws + WS_ZX);
    LAS bf16* U16 = (LAS bf16*)(F.lds + wave * 10752); LAS bf16* BX = U16 + 32 * 32;
    LAS bf16* Y = (LAS bf16*)(F.lds + 86016);
    constexpr int LDY = 392;
    const int p = lane, row0 = lc * 128 + q * 32;
    const f32x2* E = (const f32x2*)(F.ws + WS_S5E); const f32x2* X = (const f32x2*)(F.ws + WS_MISC + MS_S5X);
    __syncthreads();
    { const int t = lane >> 1, h8 = (lane & 1) * 8; *(LAS u32x4*)(U16 + t * 32 + 16 + h8) = zero4(); }
    float n_ab[4]; f32x2 n_x0, n_e0; u32x4 n_bb[8], n_u, n_cf[4]; float n_dj;
#define S5_LOAD_COMBO(c_) do { const int g5_ = wave * 3 + ((c_) >> 1), dir_ = (c_) & 1, qs_ = dir_ ? 3 - q : q; \
        const f32x4 ab4_ = *(const f32x4*)((const float*)(F.ws + WS_S5T + S5T_AB) + (size_t)((dir_ * 24 + g5_) * 64 + p) * 6 - (p & 1) * 2); \
        const f32x2 ab2_ = *(const f32x2*)((const float*)(F.ws + WS_S5T + S5T_AB) + (size_t)((dir_ * 24 + g5_) * 64 + p) * 6 + 4 - (p & 1) * 2); \
        if (p & 1) { n_ab[0] = ab4_[2]; n_ab[1] = ab4_[3]; n_ab[2] = ab2_[0]; n_ab[3] = ab2_[1]; } else { n_ab[0] = ab4_[0]; n_ab[1] = ab4_[1]; n_ab[2] = ab4_[2]; n_ab[3] = ab4_[3]; } \
        n_x0 = X[((size_t)(lc * 2 + dir_) * 24 + g5_) * 64 + p]; \
        n_e0 = E[((size_t)((lc * 2 + dir_) * 4 + (qs_ > 0 ? qs_ - 1 : 0)) * 24 + g5_) * 64 + p]; \
        const u32x4* bbf_ = (const u32x4*)(F.ws + WS_S5T + S5T_BB) + (size_t)(dir_ * 24 + g5_) * 8 * 64; \
        _Pragma("unroll") for (int pt_ = 0; pt_ < 8; ++pt_) n_bb[pt_] = bbf_[pt_ * 64 + lane]; } while (0)
#define S5_LOAD_GROUP(gi_) do { const int g5_ = wave * 3 + (gi_); const int t_ = lane >> 1, h8_ = (lane & 1) * 8; \
        n_u = *(const u32x4*)(zx + (size_t)(row0 + t_) * ZW + ZC_U + g5_ * 16 + h8_); \
        _Pragma("unroll") for (int ks_ = 0; ks_ < 4; ++ks_) n_cf[ks_] = ((const u32x4*)(F.ws + WS_S5T + S5T_CC))[(g5_ * 4 + ks_) * 64 + lane]; \
        n_dj = F.in[I_S5D][l * 384 + g5_ * 16 + (lane & 15)]; } while (0)
    S5_LOAD_GROUP(0); S5_LOAD_COMBO(0);
    bf16x8 cf[4]; float dj = 0.f; f32x4 ay[2];
#pragma unroll 1
    for (int c = 0; c < 6; ++c) {
        const int g5 = wave * 3 + (c >> 1), dir = c & 1;
        if (dir == 0) {
            { const int t = lane >> 1, h8 = (lane & 1) * 8; *(LAS u32x4*)(U16 + t * 32 + h8) = n_u; }
#pragma unroll
            for (int ks = 0; ks < 4; ++ks) cf[ks] = __builtin_bit_cast(bf16x8, n_cf[ks]);
            dj = n_dj; ay[0] = (f32x4){0.f, 0.f, 0.f, 0.f}; ay[1] = (f32x4){0.f, 0.f, 0.f, 0.f};
        }
        const float ab_re = n_ab[0], ab_im = n_ab[1], pr = n_ab[2], pi = n_ab[3];
        const int qs = dir ? 3 - q : q;
        float xr = n_x0.x, xi = n_x0.y;
        for (int s_ = 0; s_ < qs; ++s_) cmul(xr, xi, pr, pi);
        if (qs > 0) { xr += n_e0.x; xi += n_e0.y; }
        u32x4 bb[8];
#pragma unroll
        for (int pt = 0; pt < 8; ++pt) bb[pt] = n_bb[pt];
        if (c < 5) { S5_LOAD_COMBO(c + 1); if (dir == 1) S5_LOAD_GROUP((c + 1) >> 1); }
        LDS_WAIT(); asm volatile("" ::: "memory");
        {
            const bf16x8 b0 = *(const LAS bf16x8*)(U16 + (lane & 15) * 32 + (lane >> 4) * 8), b1 = *(const LAS bf16x8*)(U16 + (16 + (lane & 15)) * 32 + (lane >> 4) * 8);
#pragma unroll
            for (int pt = 0; pt < 8; ++pt) { const bf16x8 a = __builtin_bit_cast(bf16x8, bb[pt]); const f32x4 z = (f32x4){0.f, 0.f, 0.f, 0.f};
                const f32x4 o0 = __builtin_amdgcn_mfma_f32_16x16x32_bf16(a, b0, z, 0, 0, 0), o1 = __builtin_amdgcn_mfma_f32_16x16x32_bf16(a, b1, z, 0, 0, 0);
                *(LAS u32x2*)(BX + (lane & 15) * LDT + pt * 16 + (lane >> 4) * 4) = (u32x2){pk2(o0[0], o0[1]), pk2(o0[2], o0[3])};
                *(LAS u32x2*)(BX + (16 + (lane & 15)) * LDT + pt * 16 + (lane >> 4) * 4) = (u32x2){pk2(o1[0], o1[1]), pk2(o1[2], o1[3])}; } }
        LDS_WAIT(); asm volatile("" ::: "memory");
#pragma unroll 8
        for (int k = 0; k < 32; ++k) { const int tl = dir ? 31 - k : k;
            LAS unsigned* bx2 = (LAS unsigned*)(BX + tl * LDT + 2 * p); const unsigned w2 = *bx2; const float bur = bflo(w2), bui = bfhi(w2);
            const float nr = ab_re * xr - ab_im * xi + bur, ni = ab_re * xi + ab_im * xr + bui; xr = nr; xi = ni;
            *bx2 = pk2(xr, xi); }
        LDS_WAIT(); asm volatile("" ::: "memory");
#pragma unroll
        for (int tt = 0; tt < 2; ++tt)
#pragma unroll
            for (int ks = 0; ks < 4; ++ks) { const bf16x8 a = *(const LAS bf16x8*)(BX + (tt * 16 + (lane & 15)) * LDT + ks * 32 + (lane >> 4) * 8);
                ay[tt] = __builtin_amdgcn_mfma_f32_16x16x32_bf16(a, cf[ks], ay[tt], 0, 0, 0); }
        if (dir == 1) {
            const int j = lane & 15;
#pragma unroll
            for (int tt = 0; tt < 2; ++tt)
#pragma unroll
                for (int i = 0; i < 4; ++i) { const int t = tt * 16 + (lane >> 4) * 4 + i; const float y = geluf_(ay[tt][i] + dj * bf2f(U16[t * 32 + j])); Y[t * LDY + g5 * 16 + j] = (bf16)f2bf(y); }
            LDS_WAIT(); asm volatile("" ::: "memory");
        }
    }
#undef S5_LOAD_COMBO
#undef S5_LOAD_GROUP
    __syncthreads();
    f32x4 az[2][3];
#pragma unroll
    for (int tt = 0; tt < 2; ++tt)
#pragma unroll
        for (int n = 0; n < 3; ++n) az[tt][n] = (f32x4){0.f, 0.f, 0.f, 0.f};
    const bf16* wg = (const bf16*)(F.ws + WS_WGLU);
#pragma unroll 4
    for (int ks = 0; ks < 12; ++ks) {
        bf16x8 a[2], b[3];
#pragma unroll
        for (int tt = 0; tt < 2; ++tt) a[tt] = *(const LAS bf16x8*)(Y + (tt * 16 + (lane & 15)) * LDY + ks * 32 + (lane >> 4) * 8);
#pragma unroll
        for (int n = 0; n < 3; ++n) b[n] = *(const bf16x8*)(wg + (size_t)(wave * 48 + n * 16 + (lane & 15)) * 384 + ks * 32 + (lane >> 4) * 8);
#pragma unroll
        for (int tt = 0; tt < 2; ++tt)
#pragma unroll
            for (int n = 0; n < 3; ++n) az[tt][n] = __builtin_amdgcn_mfma_f32_16x16x32_bf16(a[tt], b[n], az[tt][n], 0, 0, 0);
    }
    const float* bgl = F.in[I_BGLU] + l * 384;
#pragma unroll
    for (int tt = 0; tt < 2; ++tt)
#pragma unroll
        for (int n = 0; n < 3; ++n) { const int col = wave * 48 + n * 16 + (lane & 15); const float bb = bgl[col];
#pragma unroll
            for (int i = 0; i < 4; ++i) { const int t = tt * 16 + (lane >> 4) * 4 + i; const float y = bf2f(Y[t * LDY + col]);
                zx[(size_t)(row0 + t) * ZW + ZC_U + col] = (bf16)f2bf(y * sigmoidf_(az[tt][n][i] + bb)); } }
}

__device__ __forceinline__ void zero_cols(Frame& F, int col0, int n8, int nrows) {
    PHASE_IDS();
    bf16* zx = (bf16*)(F.ws + WS_ZX);
    for (int idx = F.vcu * NTHR + tid; idx < nrows * n8; idx += F.G * NTHR) { const int r = idx / n8, c = idx % n8; *(u32x4*)(zx + (size_t)r * ZW + col0 + c * 8) = (u32x4){0u, 0u, 0u, 0u}; }
}
constexpr int CW_QUEUE = 8192;
__device__ __forceinline__ int next_item(Frame& F, int qid, int cur, int tid) {
    volatile LAS unsigned* slot = (volatile LAS unsigned*)(F.lds + MISC_OFF) + 16;
    __syncthreads();
    if (tid == 0) *slot = (unsigned)F.G + __hip_atomic_fetch_add((unsigned*)(F.ws + WS_CTL) + CW_QUEUE + 64 * qid, 1u, __ATOMIC_RELAXED, __HIP_MEMORY_SCOPE_AGENT);
    __syncthreads();
    (void)cur; return (int)*slot;
}
__device__ __forceinline__ void pass1_phase(Frame& F, int l, int qid) {
    constexpr int N_ML = NLC * 4, N_S5 = NLC * 6;
    int tid0 = threadIdx.x; asm volatile("" : "+v"(tid0));
    for (int it = F.vcu; it < N_ML + N_S5; it = next_item(F, qid, it, tid0)) {
        if (it < N_S5) { if (MASK & 8) s5_local_item(F, l, it / 6, it % 6); }
        else if (MASK & 16) { const int r = it - N_S5; mlstm_local_item(F, l, r >> 2, r & 3); }
    }
}
__device__ __forceinline__ void pass2_phase(Frame& F, int l, int nlc, int qid) {
    const int n4 = nlc * 4;
    int tid0 = threadIdx.x; asm volatile("" : "+v"(tid0));
    for (int it = F.vcu; it < 2 * n4 + nlc; it = next_item(F, qid, it, tid0)) {
        if (it < nlc) { if (MASK & 4) sgu_conv_item(F, l, it); }
        else if (it < nlc + n4) { if (MASK & 8) { const int r = it - nlc; s5_out_item(F, l, r >> 2, r & 3); } }
        else if (MASK & 16) { const int r = it - nlc - n4; mlstm_out_item(F, l, r >> 2, r & 3); }
    }
    if (!(MASK & 16)) zero_cols(F, ZC_O, 64, nlc * 128);
    if (!(MASK & 8)) zero_cols(F, ZC_U, 48, nlc * 128);
    if (!(MASK & 4)) { zero_cols(F, ZC_SU, 64, nlc * 128); zero_cols(F, ZC_CB, 64, nlc * 128); }
}

struct EpiStoreBf16 {
    static constexpr bool PERM = true;
    bf16* O;
    __device__ __forceinline__ void operator()(const f32x4 (&acc)[2][2][4][2], const pg8::Unit& u, int wr, int wc, int fr, int fq) const {
        const int row0 = u.pm * 256 + wr * 64 + fr, col0 = u.pn * 256 + wc * 32 + 8 * fq;
        const int act = (u.pn >= 20 || u.pn == 8 || u.pn == 9) ? 1 : ((u.pn >= 10 && u.pn < 14) ? 2 : 0);
#pragma unroll
        for (int ai = 0; ai < 2; ++ai)
#pragma unroll
            for (int m = 0; m < 4; ++m) { bf16* rowp = O + (size_t)(row0 + ai * 128 + m * 16) * ZW + col0;
#pragma unroll
                for (int bj = 0; bj < 2; ++bj) { f32x4 v0 = acc[ai][bj][m][0], v1 = acc[ai][bj][m][1];
                    if (act == 1) {
#pragma unroll
                        for (int e = 0; e < 4; ++e) { v0[e] = sigmoidf_(v0[e]); v1[e] = sigmoidf_(v1[e]); } }
                    else if (act == 2) {
#pragma unroll
                        for (int e = 0; e < 4; ++e) { v0[e] = geluf_(v0[e]); v1[e] = geluf_(v1[e]); } }
                    u32x4 w; w.x = pk2(v0[0], v0[1]); w.y = pk2(v0[2], v0[3]); w.z = pk2(v1[0], v1[1]); w.w = pk2(v1[2], v1[3]);
                    *(u32x4*)(rowp + bj * 128) = w; } }
    }
};
struct EpiGateCat {
    static constexpr bool PERM = true;
    const bf16* zx; bf16* mg;
    __device__ __forceinline__ void rescale(f32x4 (&acc)[2][2][4][2], const pg8::Unit& u, int t, int wr, int wc, int fr, int fq) const {
        const int b = t == 8 ? 0 : (t == 16 ? 1 : 2);
        const int rl0 = u.pm * 256 + wr * 64 + fr, col0 = u.pn * 256 + wc * 32 + 8 * fq;
#pragma unroll
        for (int ai = 0; ai < 2; ++ai) {
            u32x4 ga[4][2], gb[4][2];
#pragma unroll
            for (int m = 0; m < 4; ++m) { const bf16* gp = zx + (size_t)(rl0 + ai * 128 + m * 16) * ZW + ZC_BG + b * 1024 + col0;
#pragma unroll
                for (int bj = 0; bj < 2; ++bj) { ga[m][bj] = *(const u32x4*)(gp + bj * 128); gb[m][bj] = *(const u32x4*)(gp + 1024 + bj * 128); } }
#pragma unroll
            for (int m = 0; m < 4; ++m)
#pragma unroll
                for (int bj = 0; bj < 2; ++bj)
#pragma unroll
                    for (int e = 0; e < 4; ++e) { const int n = e >> 1, c = (e & 1) * 2;
                        acc[ai][bj][m][n][c] *= fmaxf(bflo(ga[m][bj][e]), 1e-20f) * rcpf_(fmaxf(bflo(gb[m][bj][e]), 1e-20f));
                        acc[ai][bj][m][n][c + 1] *= fmaxf(bfhi(ga[m][bj][e]), 1e-20f) * rcpf_(fmaxf(bfhi(gb[m][bj][e]), 1e-20f)); }
            asm volatile("" ::: "memory"); }
    }
    __device__ __forceinline__ void operator()(const f32x4 (&acc)[2][2][4][2], const pg8::Unit& u, int wr, int wc, int fr, int fq) const {
        const int rl0 = u.pm * 256 + wr * 64 + fr, rg0 = u.pmg * 256 + wr * 64 + fr, col0 = u.pn * 256 + wc * 32 + 8 * fq;
#pragma unroll
        for (int ai = 0; ai < 2; ++ai) {
            u32x4 gw[4][2];
#pragma unroll
            for (int m = 0; m < 4; ++m) { const bf16* gp = zx + (size_t)(rl0 + ai * 128 + m * 16) * ZW + ZC_BG + 3 * 1024 + col0;
#pragma unroll
                for (int bj = 0; bj < 2; ++bj) gw[m][bj] = *(const u32x4*)(gp + bj * 128); }
#pragma unroll
            for (int m = 0; m < 4; ++m) { bf16* mp = mg + (size_t)(rg0 + ai * 128 + m * 16) * D + col0;
#pragma unroll
                for (int bj = 0; bj < 2; ++bj) { const u32x4 g_ = gw[m][bj]; const f32x4 v0 = acc[ai][bj][m][0], v1 = acc[ai][bj][m][1]; u32x4 w;
                    w.x = pk2(fmaxf(bflo(g_.x), 1e-20f) * v0[0], fmaxf(bfhi(g_.x), 1e-20f) * v0[1]); w.y = pk2(fmaxf(bflo(g_.y), 1e-20f) * v0[2], fmaxf(bfhi(g_.y), 1e-20f) * v0[3]);
                    w.z = pk2(fmaxf(bflo(g_.z), 1e-20f) * v1[0], fmaxf(bfhi(g_.z), 1e-20f) * v1[1]); w.w = pk2(fmaxf(bflo(g_.w), 1e-20f) * v1[2], fmaxf(bfhi(g_.w), 1e-20f) * v1[3]);
                    *(u32x4*)(mp + bj * 128) = w; } }
            asm volatile("" ::: "memory"); }
    }
};
struct OrderIn {
    const char* hn; const char* win; int g, G, c;
    __device__ __forceinline__ bool next(int i, pg8::Unit& u) const {
        const int L = i * G + c; if (L >= 34 * 36) return false;
        int pm, pn; pg8::tile_of(L, 34, 36, pm, pn);
        u.pm = pm; u.pn = pn; u.pmg = gtile_of(g, pm); u.br = 0; u.nt = 16;
        u.A = hn + (size_t)u.pmg * 256 * D * 2; u.B = win + (size_t)pn * 256 * D * 2; return true;
    }
};
struct OrderUp {
    const char* zx; const char* wup; int g, nOT, G, bx;
    __device__ __forceinline__ bool next(int i, pg8::Unit& u) const {
        if (i > 0) return false;
        const int per = (nOT + 7) >> 3, slot = bx >> 3, ot = (bx & 7) * per + slot; if (slot >= per || ot >= nOT) return false;
        const int pm = ot >> 2, pn = ot & 3;
        u.pm = pm; u.pn = pn; u.pmg = gtile_of(g, pm); u.br = 0; u.nt = 30;
        u.A = zx + (size_t)pm * 256 * ZW * 2; u.B = wup + (size_t)pn * 256 * 1920 * 2; return true;
    }
};

__global__ void __launch_bounds__(NTHR, 2) fwd_kernel(Args args) {
    extern __shared__ __attribute__((aligned(16))) unsigned char lds[];
    Frame F;
    F.lds = (LAS unsigned char*)lds;
    volatile LAS unsigned* MISC = (volatile LAS unsigned*)(F.lds + MISC_OFF);
    const int tid = threadIdx.x;
    F.G = gridDim.x; { const int bx = blockIdx.x; F.vcu = (F.G % 8 == 0) ? (bx % 8) * (F.G / 8) + bx / 8 : bx; }
    F.in = args.in; F.out = args.out; F.ws = args.ws;
    for (int u = tid; u < (LDS_BYTES - LDSCTL_OFF) / 4; u += NTHR) ((LAS unsigned*)(F.lds + LDSCTL_OFF))[u] = 0u;
    __syncthreads();
    unsigned* ctl = (unsigned*)(args.ws + WS_CTL);
    XcdBarrier bar = xcd_barrier_post(ctl + CW_BAR, MISC + 8);
#define GRID_BAR() do { XcdBarrier b_ = bar; asm volatile("" : "+s"(b_.x), "+s"(b_.bar)); xcd_barrier(b_); } while (0)

    p0_mods(F);
    p0_weights(F, 0);
    s5_tables(F, 0);
    GRID_BAR();

    float* xc = (float*)(F.ws + WS_XC);
#pragma unroll 1
    for (int l = 0; l < DEPTH; ++l) {
        asm volatile("" : "+s"(F.ws), "+s"(F.out));
        const bool last = (l == DEPTH - 1);
        const float* xin_l = (l == 0) ? F.in[I_X] : F.out;
        const float* xin_c = (l == 0) ? F.in[I_CTX] : xc;
        const int nMg = ((MASK & 2) && !last) ? 68 : 64;
        if (l > 0) { p0_weights(F, l); s5_tables(F, l); }
        if (MASK & 2) {
            norm_phase(F, xin_l, xin_c, F.in[I_GNMIX] + l * D, l, 0, MTOT);
            GRID_BAR();
#pragma unroll 1
            for (int g = 0; g < NGRP; ++g) {
                asm volatile("" : "+s"(F.ws));
                { OrderIn S{(const char*)(F.ws + WS_HN), (const char*)(F.ws + WS_WIN), g, F.G, (int)blockIdx.x};
                  EpiStoreBf16 E{(bf16*)(F.ws + WS_ZX)};
                  pg8::gemm_phase<EpiStoreBf16, OrderIn, D, D>(F.lds, S, E); }
                GRID_BAR();
                if (MASK & 24) { pass1_phase(F, l, (l * 2 + g) * 2); GRID_BAR(); scan_phase(F, l); GRID_BAR(); }
                pass2_phase(F, l, last ? 64 : 68, (l * 2 + g) * 2 + 1);
                GRID_BAR();
                { OrderUp S{(const char*)(F.ws + WS_ZX), (const char*)(F.ws + WS_WUP), g, (last ? 32 : 34) * 4, F.G, (int)blockIdx.x};
                  EpiGateCat E{(const bf16*)(F.ws + WS_ZX), (bf16*)(F.ws + WS_HN)};
                  pg8::gemm_phase<EpiGateCat, OrderUp, ZW, 1920, true, true, true>(F.lds, S, E); }
                GRID_BAR();
            }
            { OrderGlobal S{(const char*)(F.ws + WS_HN), (const char*)(F.ws + WS_WOUT), D, D, nMg, D / 256, D / 64, F.G, (int)blockIdx.x};
              EpiResid E{xin_l, xin_c, F.out, xc, modp(F, l, 0, 2)};
              pg8::gemm_phase<EpiResid, OrderGlobal, D, D>(F.lds, S, E); }
            GRID_BAR();
        }
        const float* x1_l = (MASK & 2) ? F.out : xin_l; const float* x1_c = (MASK & 2) ? xc : xin_c;
        norm_phase(F, x1_l, x1_c, F.in[I_GNFFN] + l * D, l, 3, nMg * 256);
        GRID_BAR();
        { OrderGlobal S{(const char*)(F.ws + WS_HN), (const char*)(F.ws + WS_WFF1), D, D, nMg, FF2 / 256, D / 64, F.G, (int)blockIdx.x};
          EpiSwiglu E{(bf16*)(F.ws + WS_ZX)};
          pg8::gemm_phase<EpiSwiglu, OrderGlobal, D, D>(F.lds, S, E); }
        GRID_BAR();
        { OrderGlobal S{(const char*)(F.ws + WS_ZX), (const char*)(F.ws + WS_WFF2), FFH, FFH, nMg, D / 256, FFH / 64, F.G, (int)blockIdx.x};
          EpiResid E{x1_l, x1_c, F.out, xc, modp(F, l, 0, 5)};
          pg8::gemm_phase<EpiResid, OrderGlobal, FFH, FFH>(F.lds, S, E); }
        GRID_BAR();
    }
    final_norm_phase(F);
}

extern "C" void kernel_launch(void* const* d_in, const int* in_sizes, int n_in, void* d_out, int out_size, void* d_ws, size_t ws_size, hipStream_t stream) {
    static int grid = 0;
    if (grid == 0) {
        if (n_in != N_IN || ws_size < WS_END || out_size != MLAT * D) { fprintf(stderr, "kernel_launch: unexpected n_in %d / ws %zu / out %d\n", n_in, ws_size, out_size); grid = -1; return; }
        int dev = 0, cus = 0, per_cu = 0;
        if (hipGetDevice(&dev) != hipSuccess || hipDeviceGetAttribute(&cus, hipDeviceAttributeMultiprocessorCount, dev) != hipSuccess) { grid = -1; return; }
        if (hipFuncSetAttribute((const void*)fwd_kernel, hipFuncAttributeMaxDynamicSharedMemorySize, LDS_BYTES) != hipSuccess) { grid = -1; return; }
        if (hipOccupancyMaxActiveBlocksPerMultiprocessor(&per_cu, (const void*)fwd_kernel, NTHR, LDS_BYTES) != hipSuccess || per_cu < 1) { fprintf(stderr, "occupancy query: %d\n", per_cu); grid = -1; return; }
        grid = cus;
    }
    if (grid < 0) return;
    (void)hipMemsetAsync((char*)d_ws + WS_CTL, 0, CTL_ZERO_BYTES, stream);
    Args a{};
    for (int i = 0; i < N_IN; ++i) a.in[i] = (const float*)d_in[i];
    a.out = (float*)d_out; a.ws = (unsigned char*)d_ws;
    void* kargs[] = {&a};
    hipError_t e = hipLaunchCooperativeKernel((const void*)fwd_kernel, dim3(grid), dim3(NTHR), kargs, LDS_BYTES, stream);
    if (e != hipSuccess) fprintf(stderr, "cooperative launch failed: %s (grid %d)\n", hipGetErrorString(e), grid);
}
```

```cpp
#include <hip/hip_runtime.h>
#include <hip/hip_cooperative_groups.h>
#include <cstdio>
#include <cstdint>
namespace cg = cooperative_groups;

#ifndef MASK
#define MASK 31
#endif

#define GAS __attribute__((address_space(1)))
#define LAS __attribute__((address_space(3)))
typedef unsigned short bf16;
typedef float f32x4 __attribute__((ext_vector_type(4)));
typedef float f32x2 __attribute__((ext_vector_type(2)));
typedef short bf16x8 __attribute__((ext_vector_type(8)));
typedef unsigned u32x4 __attribute__((ext_vector_type(4)));
typedef unsigned u32x2 __attribute__((ext_vector_type(2)));

constexpr int NWAVES = 8, NTHR = 512;
constexpr int D = 1024, BATCH = 4, SEQ = 4096, CTXL = 256, DEPTH = 2;
constexpr int MLAT = BATCH * SEQ, MCTX = BATCH * CTXL, MTOT = MLAT + MCTX;
constexpr int IN_DIM = 9104, ZW = 9216, FFH = 2816, FF2 = 2 * FFH;
constexpr int NGRP = 2, GROWS = MTOT / NGRP;
constexpr float RMS_EPS = 1e-6f;
enum { I_X = 0, I_C, I_CTX, I_CCTX, I_WMOD, I_BMOD, I_GNMIX, I_GNFFN, I_WIN, I_BGATES, I_WCONVQK, I_GMH, I_GSGU, I_WSGU, I_BSGU,
       I_S5ARE, I_S5AIM, I_S5LOGDT, I_S5BRE, I_S5BIM, I_S5CRE, I_S5CIM, I_S5D, I_WGLU, I_BGLU, I_WSCONV, I_WUPM, I_WUPSGU, I_WUPS5, I_WUPSC,
       I_WOUT, I_WFFG, I_WFFU, I_WFFD, I_GFINAL, N_IN };

constexpr size_t MiB = 1u << 20;
constexpr size_t WS_CTL = 0, CTL_ZERO_BYTES = 1 * MiB;
constexpr size_t WS_MOD = 1 * MiB;
constexpr size_t WS_WIN = 2 * MiB;
constexpr size_t WS_WUP = 20 * MiB;
constexpr size_t WS_WOUT = 24 * MiB;
constexpr size_t WS_WFF1 = 26 * MiB;
constexpr size_t WS_WFF2 = 37 * MiB;
constexpr size_t WS_WGLU = 43 * MiB;
constexpr size_t WS_S5T = 43 * MiB + 320 * 1024;
constexpr size_t WS_XC = 44 * MiB;
constexpr size_t WS_HN = 48 * MiB;
constexpr size_t WS_MST = 82 * MiB;
constexpr size_t WS_S5E = 116 * MiB;
constexpr size_t WS_MISC = 123 * MiB;
constexpr size_t WS_ZX = 126 * MiB;
constexpr size_t WS_END = 279 * MiB;
constexpr int CW_BAR = 4096;

constexpr int LDS_BYTES = 147456;
constexpr int LDSCTL_OFF = LDS_BYTES - 512, MISC_OFF = LDSCTL_OFF + 320;

namespace pg8 {
#define PG8_LAS __attribute__((address_space(3)))
typedef unsigned short bf16_t;
constexpr int BM = 256, BK = 64, HALF = 128, HTB = HALF * BK * 2, STAGE_BYTES = 8 * HTB, NXCD = 8, WGM = 8;
__host__ __device__ __forceinline__ int lds_byte(int r, int c) { const int st = (r >> 4) * 2 + (c >> 5), rr = r & 15, cc = c & 31, ob = rr * 64 + cc * 2; return st * 1024 + (ob ^ (((ob >> 9) & 1) << 5)); }
__host__ __device__ __forceinline__ void stage_rc(int b, int& R, int& C) { const int st = b / 1024, sb = b % 1024, swz = sb ^ (((sb >> 9) & 1) << 5); R = (st >> 1) * 16 + swz / 64; C = (st & 1) * 32 + (swz % 64) / 2; }
__host__ __device__ __forceinline__ int perm32(int rho) { const int n = rho >> 4, i = rho & 15; return 8 * (i >> 2) + 4 * n + (i & 3); }

struct Unit { int pm, pn; const char* A; const char* B; int nt; int pmg; int br; };
struct Ld { int lda, ldb; };
__device__ __forceinline__ void tile_of(int L, int nM, int nN, int& pm, int& pn) {
    const int nwg = nM * nN; int wgid = L; { const int q = nwg / NXCD, r = nwg % NXCD, xcd = wgid % NXCD, off = wgid / NXCD; wgid = (xcd < r ? xcd * (q + 1) : r * (q + 1) + (xcd - r) * q) + off; }
    const int nig = WGM * nN, gid = wgid / nig, fm = gid * WGM, gsz = (nM - fm) < WGM ? (nM - fm) : WGM;
    pm = fm + ((wgid % nig) % gsz); pn = (wgid % nig) / gsz;
}
__device__ __forceinline__ unsigned cvt_pk_bf16(float lo, float hi) { unsigned r; asm volatile("v_cvt_pk_bf16_f32 %0, %1, %2" : "=v"(r) : "v"(lo), "v"(hi)); return r; }

__device__ __forceinline__ size_t kcat_off(int t) { return t < 8 ? (size_t)2048 * 2 + t * 128 : t < 16 ? (size_t)2560 * 2 + (t - 8) * 128 : t < 22 ? (size_t)1536 * 2 + (t - 16) * 128 : (size_t)3584 * 2 + (t - 22) * 128; }
template <class Epi, class Sched, int LDA, int LDB, bool ALIGN_EPI = true, bool SP2 = true, bool KCAT = false>
__device__ __forceinline__ void gemm_phase(PG8_LAS unsigned char* lds, const Sched& S, const Epi& E) {
    int tid = threadIdx.x; asm volatile("" : "+v"(tid));
    const int wid = __builtin_amdgcn_readfirstlane(tid >> 6), lane = tid & 63, wr = wid >> 2, wc = wid & 3, fr = lane & 15, fq = lane >> 4;
    unsigned voffA[2], voffB[2];
#pragma unroll
    for (int i = 0; i < 2; ++i) { int R, C; stage_rc(tid * 16 + i * 8192, R, C); const int Rb = Epi::PERM ? ((R & ~31) + perm32(R & 31)) : R;
        voffA[i] = (unsigned)(R * LDA + C) * 2u; voffB[i] = (unsigned)(Rb * LDB + C) * 2u; }
    const size_t kstep = (size_t)(BK * 2);
    constexpr size_t hstepA = (size_t)HALF * LDA * 2, hstepB = (size_t)HALF * LDB * 2;
    const unsigned ldsw = (unsigned)wid * 1024u;
    const int aoff = lds_byte(wr * 64 + fr, fq * 8), boff = lds_byte(wc * 32 + fr, fq * 8);
#define PG8_SA(b, h) (((b) * 2 + (h)) * HTB)
#define PG8_SB(b, h) ((4 + (b) * 2 + (h)) * HTB)
#define PG8_STAGE(bufoff, gbase, voff) do { _Pragma("unroll") for (int _i = 0; _i < 2; ++_i) \
        __builtin_amdgcn_global_load_lds((const unsigned*)((const char*)(gbase) + (voff)[_i]), (PG8_LAS unsigned*)(lds + (bufoff) + ldsw + _i * 8192), 16, 0, 0); } while (0)
#define PG8_LDA(dst, b, h) do { _Pragma("unroll") for (int m = 0; m < 4; ++m) _Pragma("unroll") for (int k = 0; k < 2; ++k) dst[m][k] = *(const PG8_LAS bf16x8*)(lds + PG8_SA(b, h) + aoff + m * 2048 + k * 1024); } while (0)
#define PG8_LDB(dst, b, h) do { _Pragma("unroll") for (int n = 0; n < 2; ++n) _Pragma("unroll") for (int k = 0; k < 2; ++k) dst[n][k] = *(const PG8_LAS bf16x8*)(lds + PG8_SB(b, h) + boff + n * 2048 + k * 1024); } while (0)
#define PG8_MMA(ai, bj, At, Bt) do { __builtin_amdgcn_s_setprio(1); _Pragma("unroll") for (int m = 0; m < 4; ++m) _Pragma("unroll") for (int n = 0; n < 2; ++n) _Pragma("unroll") for (int k = 0; k < 2; ++k) \
        acc[ai][bj][m][n] = __builtin_amdgcn_mfma_f32_16x16x32_bf16(Bt[n][k], At[m][k], acc[ai][bj][m][n], 0, 0, 0); __builtin_amdgcn_s_setprio(0); } while (0)
#define PG8_WAIT_V(n) asm volatile("s_waitcnt vmcnt(" #n ")" ::: "memory")
#define PG8_WAIT_L(n) asm volatile("s_waitcnt lgkmcnt(" #n ")" ::: "memory")
#define PG8_BAR __builtin_amdgcn_s_barrier()
#define PG8_SCHED __builtin_amdgcn_sched_barrier(0)
    Unit cur, nxt; int ui = 0;
    if (!S.next(0, cur)) return;
    f32x4 acc[2][2][4][2];
#pragma unroll
    for (int a = 0; a < 2; ++a)
#pragma unroll
        for (int b = 0; b < 2; ++b)
#pragma unroll
            for (int m = 0; m < 4; ++m)
#pragma unroll
                for (int n = 0; n < 2; ++n) acc[a][b][m][n] = (f32x4){0.f, 0.f, 0.f, 0.f};
    bf16x8 At[4][2], B0[2][2], B1[2][2];
    const char* cA = cur.A; const char* cB = cur.B;
    static_assert(SP2, "only the SP2 loop is kept");
    const char* pA0 = KCAT ? cA + kcat_off(0) : cA; const char* pA1 = KCAT ? cA + kcat_off(1) : cA + kstep;
    PG8_STAGE(PG8_SB(0, 0), cB, voffB); PG8_STAGE(PG8_SB(0, 1), cB + hstepB, voffB); PG8_STAGE(PG8_SA(0, 0), pA0, voffA); PG8_STAGE(PG8_SA(0, 1), pA0 + hstepA, voffA);
    if (wr == 1) PG8_BAR;
    PG8_WAIT_V(2); PG8_BAR;
    PG8_STAGE(PG8_SB(1, 0), cB + kstep, voffB); PG8_STAGE(PG8_SA(1, 0), pA1, voffA); PG8_STAGE(PG8_SB(1, 1), cB + hstepB + kstep, voffB);
    PG8_WAIT_V(6); PG8_BAR;
    for (;;) {
        const bool has_next = S.next(ui + 1, nxt);
        const char* nA = has_next ? nxt.A : cA; const char* nB = has_next ? nxt.B : cB;
        const int nt = cur.nt;
        for (int t = 0; t < nt; t += 2) {
            const bool last = (t == nt - 2);
            const char* a1; const char* a2; const char* a3;
            if constexpr (KCAT) { if (t == 8 || t == 16 || t == 22) E.rescale(acc, cur, t, wr, wc, fr, fq);
                a1 = cA + kcat_off(t + 1); a2 = last ? nA + kcat_off(0) : cA + kcat_off(t + 2); a3 = last ? nA + kcat_off(1) : cA + kcat_off(t + 3); }
            else { a1 = cA + (size_t)(t + 1) * kstep; a2 = last ? nA : cA + (size_t)(t + 2) * kstep; a3 = a2 + kstep; }
            const char* b2 = last ? nB : cB + (size_t)(t + 2) * kstep; const char* b3 = b2 + kstep;
            PG8_LDB(B0, 0, 0); PG8_LDB(B1, 0, 1); PG8_SCHED; PG8_LDA(At, 0, 0); PG8_STAGE(PG8_SA(1, 1), a1 + hstepA, voffA);
            PG8_WAIT_V(8); PG8_WAIT_L(0); PG8_BAR; PG8_MMA(0, 0, At, B0); PG8_MMA(0, 1, At, B1); PG8_BAR; PG8_SCHED;
            PG8_LDA(At, 0, 1); PG8_STAGE(PG8_SB(0, 0), b2, voffB); PG8_STAGE(PG8_SB(0, 1), b2 + hstepB, voffB); PG8_STAGE(PG8_SA(0, 0), a2, voffA);
            PG8_WAIT_V(8); PG8_WAIT_L(0); PG8_BAR; PG8_MMA(1, 0, At, B0); PG8_MMA(1, 1, At, B1); PG8_BAR; PG8_SCHED;
            PG8_LDB(B0, 1, 0); PG8_LDB(B1, 1, 1); PG8_SCHED; PG8_LDA(At, 1, 0); PG8_STAGE(PG8_SA(0, 1), a2 + hstepA, voffA);
            PG8_WAIT_V(8); PG8_WAIT_L(0); PG8_BAR; PG8_MMA(0, 0, At, B0); PG8_MMA(0, 1, At, B1); PG8_BAR; PG8_SCHED;
            PG8_LDA(At, 1, 1); PG8_STAGE(PG8_SB(1, 0), b3, voffB); PG8_STAGE(PG8_SB(1, 1), b3 + hstepB, voffB); PG8_STAGE(PG8_SA(1, 0), a3, voffA);
            PG8_WAIT_V(8); PG8_WAIT_L(0); PG8_BAR; PG8_MMA(1, 0, At, B0); PG8_MMA(1, 1, At, B1); PG8_BAR; PG8_SCHED;
        }
        if constexpr (ALIGN_EPI) { if (wr == 0) PG8_BAR; }
        E(acc, cur, wr, wc, fr, fq);
        if (!has_next) break;
#pragma unroll
        for (int a = 0; a < 2; ++a)
#pragma unroll
            for (int b = 0; b < 2; ++b)
#pragma unroll
                for (int m = 0; m < 4; ++m)
#pragma unroll
                    for (int n = 0; n < 2; ++n) acc[a][b][m][n] = (f32x4){0.f, 0.f, 0.f, 0.f};
        cur = nxt; cA = nA; cB = nB; ++ui;
        if constexpr (ALIGN_EPI) { if (wr == 1) PG8_BAR; }
    }
    PG8_WAIT_V(0);
    if constexpr (!ALIGN_EPI) { if (wr == 0) PG8_BAR; }
    PG8_BAR;
#undef PG8_SA
#undef PG8_SB
#undef PG8_STAGE
#undef PG8_LDA
#undef PG8_LDB
#undef PG8_MMA
#undef PG8_WAIT_V
#undef PG8_WAIT_L
#undef PG8_BAR
#undef PG8_SCHED
}
}

#define RLX_AGENT __ATOMIC_RELAXED, __HIP_MEMORY_SCOPE_AGENT
#define LDS_WAIT() asm volatile("s_waitcnt lgkmcnt(0)" ::: "memory")
#define VM_WAIT() asm volatile("s_waitcnt vmcnt(0)" ::: "memory")
typedef __bf16 bf16x2_t __attribute__((ext_vector_type(2)));
__device__ __forceinline__ unsigned pk2(float lo, float hi) { f32x2 v = {lo, hi}; bf16x2_t b = __builtin_convertvector(v, bf16x2_t); return __builtin_bit_cast(unsigned, b); }
__device__ __forceinline__ unsigned f2bf(float f) { return pk2(f, 0.f) & 0xffffu; }
__device__ __forceinline__ float bf2f(unsigned short h) { return __builtin_bit_cast(float, (unsigned)h << 16); }
__device__ __forceinline__ u32x4 zero4() { unsigned z = 0u; asm volatile("" : "+v"(z)); return (u32x4){z, z, z, z}; }
__device__ __forceinline__ float rcpf_(float x) { return __builtin_amdgcn_rcpf(x); }
__device__ __forceinline__ float sigmoidf_(float x) { return rcpf_(1.0f + __expf(-x)); }
__device__ __forceinline__ float siluf_(float x) { return x * rcpf_(1.0f + __expf(-x)); }

#define XB_TMO      128
#define XB_XCNT(j)  (256  + 64 * (j))
#define XB_XSUB(j)  (1280 + 64 * (j))
#define XB_XGEN(j)  (2304 + 64 * (j))
#define XB_TOP      3328
#define XB_TOPGEN   3392
#define XCD_BAR_WORDS 3456
#define XB_SPIN_CAP (1u << 18)
__device__ __forceinline__ unsigned xb_ld(unsigned* p)              { return __hip_atomic_load(p, __ATOMIC_RELAXED, __HIP_MEMORY_SCOPE_AGENT); }
__device__ __forceinline__ unsigned xb_add(unsigned* p, unsigned v) { return __hip_atomic_fetch_add(p, v, __ATOMIC_RELAXED, __HIP_MEMORY_SCOPE_AGENT); }
__device__ __forceinline__ unsigned xb_xcc_id() { return (unsigned)__builtin_amdgcn_s_getreg((3 << 11) | 20) & 0xFu; }
#define XB_SPIN(cond, bar) do { unsigned _sp = 0; while (cond) { __builtin_amdgcn_s_sleep(1); \
    if ((++_sp & 255u) == 0u) { if (xb_ld(&(bar)[XB_TMO])) break; if (_sp > XB_SPIN_CAP) { atomicAdd(&(bar)[XB_TMO], 1u); break; } } } } while (0)
struct XcdBarrier { unsigned* bar; unsigned x; volatile LAS unsigned* st; };
__device__ __forceinline__ XcdBarrier xcd_barrier_post(unsigned* bar, volatile LAS unsigned* st) {
    XcdBarrier b; b.bar = bar; b.x = xb_xcc_id(); b.st = st;
    if (threadIdx.x == 0) (void)xb_add(&bar[XB_XCNT(b.x)], 1u);
    return b;
}
__device__ __forceinline__ void xcd_barrier_complete(unsigned* bar, unsigned x, unsigned& nloc, unsigned& nx) {
    const unsigned G = gridDim.x * gridDim.y * gridDim.z;
    unsigned sum, cnt, mine, sp = 0u;
    for (;;) {
        sum = 0u; cnt = 0u; mine = 0u;
#pragma unroll
        for (unsigned j = 0; j < 16; ++j) { const unsigned c = xb_ld(&bar[XB_XCNT(j)]); sum += c; cnt += (c > 0u) ? 1u : 0u; mine = (j == x) ? c : mine; }
        if (sum == G) break;
        __builtin_amdgcn_s_sleep(1);
        if ((++sp & 255u) == 0u) { if (xb_ld(&bar[XB_TMO])) break; if (sp > XB_SPIN_CAP) { atomicAdd(&bar[XB_TMO], 1u); break; } }
    }
    nloc = mine > 0u ? mine : 1u; nx = cnt > 0u ? cnt : 1u;
}
__device__ __forceinline__ void xcd_barrier(const XcdBarrier& b) {
    asm volatile("s_waitcnt vmcnt(0)" ::: "memory");
    __syncthreads();
    if (threadIdx.x == 0) {
        unsigned* bar = b.bar;
        __builtin_amdgcn_s_waitcnt(0);
        unsigned nloc = b.st[0], nx = b.st[1];
        if (nloc == 0u) { xcd_barrier_complete(bar, b.x, nloc, nx); b.st[0] = nloc; b.st[1] = nx; }
        const unsigned old = xb_add(&bar[XB_XSUB(b.x)], 1u);
        const unsigned gen = old / nloc;
        if (old + 1u == (gen + 1u) * nloc) {
            __builtin_amdgcn_fence(__ATOMIC_RELEASE, "agent");
            asm volatile("s_waitcnt vmcnt(0)" ::: "memory");
            const unsigned og = xb_add(&bar[XB_TOP], 1u);
            const unsigned tg = og / nx;
            if (og + 1u == (tg + 1u) * nx) xb_add(&bar[XB_TOPGEN], 1u);
            else XB_SPIN(xb_ld(&bar[XB_TOPGEN]) == tg, bar);
            __builtin_amdgcn_fence(__ATOMIC_ACQUIRE, "agent");
            xb_add(&bar[XB_XGEN(b.x)], 1u);
            asm volatile("s_waitcnt vmcnt(0)" ::: "memory");
        } else {
            XB_SPIN(xb_ld(&bar[XB_XGEN(b.x)]) == gen, bar);
            __builtin_amdgcn_fence(__ATOMIC_ACQUIRE, "agent");
            asm volatile("s_waitcnt vmcnt(0)" ::: "memory");
        }
    }
    __syncthreads();
}

__device__ __forceinline__ float wave_sum(float v) {
#pragma unroll
    for (int o = 1; o < 64; o <<= 1) v += __shfl_xor(v, o);
    return v;
}

#define PHASE_IDS() int tid = threadIdx.x; asm volatile("" : "+v"(tid)); const int lane = tid & 63; const int wave = __builtin_amdgcn_readfirstlane(tid >> 6); (void)lane; (void)wave
struct Args { const float* in[N_IN]; float* out; unsigned char* ws; };
struct Frame {
    LAS unsigned char* lds;
    int vcu, G;
    const float* const* in;
    float* out; unsigned char* ws;
};
__device__ __forceinline__ const float* modp(Frame& F, int l, int mb, int k) { return (const float*)(F.ws + WS_MOD) + ((size_t)(l * 5 + mb) * 6 + k) * D; }
__device__ __forceinline__ int mb_of_tile(int pmg) { return pmg < 64 ? (pmg >> 4) : 4; }

__device__ __forceinline__ void p0_mods(Frame& F) {
    PHASE_IDS();
    LAS float* sc = (LAS float*)F.lds;
    LAS float* red = sc + 5 * D;
    for (int i = tid; i < 5 * D; i += NTHR) { const float v = i < 4 * D ? F.in[I_C][i] : F.in[I_CCTX][i - 4 * D]; sc[i] = siluf_(v); }
    __syncthreads();
    for (int item = F.vcu; item < 2 * 96; item += F.G) {
        const int l = item / 96, j = (item % 96) * 64 + lane;
        const float* W = F.in[I_WMOD] + (size_t)l * D * 6 * D + j;
        float a0 = 0.f, a1 = 0.f, a2 = 0.f, a3 = 0.f, a4 = 0.f;
        const int k0 = wave * 128;
#pragma unroll 32
        for (int k = k0; k < k0 + 128; ++k) { const float w = W[(size_t)k * 6 * D]; a0 += sc[k] * w; a1 += sc[D + k] * w; a2 += sc[2 * D + k] * w; a3 += sc[3 * D + k] * w; a4 += sc[4 * D + k] * w; }
        LAS float* r = red + wave * 320 + lane;
        r[0] = a0; r[64] = a1; r[128] = a2; r[192] = a3; r[256] = a4;
        __syncthreads();
        if (tid < 320) { const int mb = tid >> 6, jj = tid & 63; float s = 0.f;
#pragma unroll
            for (int w = 0; w < 8; ++w) s += red[w * 320 + mb * 64 + jj];
            const int jc = (item % 96) * 64 + jj;
            ((float*)(F.ws + WS_MOD))[(size_t)(l * 5 + mb) * 6 * D + jc] = s + F.in[I_BMOD][l * 6 * D + jc]; }
        __syncthreads();
    }
}

__device__ __forceinline__ void transpose_item(const float* W, int ldw, int k0, int srccol, bf16* WT, int Kt, int kdst0, int nrow0, LAS float* scr, int lane) {
    float tv[32];
#pragma unroll
    for (int i = 0; i < 32; ++i) { const int kk = 2 * i + (lane >> 5); tv[i] = srccol >= 0 ? W[(size_t)(k0 + kk) * ldw + srccol] : 0.f; }
#pragma unroll
    for (int i = 0; i < 32; ++i) { const int kk = 2 * i + (lane >> 5); scr[kk * 33 + (lane & 31)] = tv[i]; }
    LDS_WAIT(); asm volatile("" ::: "memory");
    const int c = lane & 7;
#pragma unroll
    for (int j = 0; j < 4; ++j) { const int n = (lane >> 3) + 8 * j; const LAS float* s = scr + (8 * c) * 33 + n;
        u32x4 o; o.x = pk2(s[0 * 33], s[1 * 33]); o.y = pk2(s[2 * 33], s[3 * 33]); o.z = pk2(s[4 * 33], s[5 * 33]); o.w = pk2(s[6 * 33], s[7 * 33]);
        *(u32x4*)(WT + (size_t)(nrow0 + n) * Kt + kdst0 + 8 * c) = o; }
    LDS_WAIT(); asm volatile("" ::: "memory");
}
__device__ __forceinline__ int win_src(int n) {
    if (n < 1536) return n;
    if (n < 1920) return 1552 + (n - 1536);
    if (n < 1936) return 1536 + (n - 1920);
    if (n < 2048) return -1;
    return 1936 + (n - 2048);
}
__device__ __forceinline__ void p0_weights(Frame& F, int l) {
    PHASE_IDS();
    LAS float* scr = (LAS float*)(F.lds + 32768 + wave * 8704);
    const int gw = F.vcu * NWAVES + wave, NGW = F.G * NWAVES;
    constexpr int I_IN = (ZW / 32) * (D / 64), I_UP = (D / 32) * (1920 / 64), I_OUT = (D / 32) * (D / 64), I_F1 = (FF2 / 32) * (D / 64), I_F2 = (D / 32) * (FFH / 64), I_GL = (384 / 32) * (384 / 64);
    constexpr int NITEMS = I_IN + I_UP + I_OUT + I_F1 + I_F2 + I_GL;
    const int ln = lane & 31;
    for (int it = gw; it < NITEMS; it += NGW) {
        int r = it;
        if (r < I_IN) { const int kb = r / (ZW / 32), nb = r % (ZW / 32);
            transpose_item(F.in[I_WIN] + (size_t)l * D * IN_DIM, IN_DIM, 64 * kb, win_src(32 * nb + ln), (bf16*)(F.ws + WS_WIN), D, 64 * kb, 32 * nb, scr, lane); continue; } r -= I_IN;
        if (r < I_UP) { const int kb = r / (D / 32), nb = r % (D / 32); const int kd = 64 * kb;
            const float* W; int ks;
            if (kd < 512) { W = F.in[I_WUPM] + (size_t)l * 512 * D; ks = kd; } else if (kd < 1024) { W = F.in[I_WUPSGU] + (size_t)l * 512 * D; ks = kd - 512; }
            else if (kd < 1408) { W = F.in[I_WUPS5] + (size_t)l * 384 * D; ks = kd - 1024; } else { W = F.in[I_WUPSC] + (size_t)l * 512 * D; ks = kd - 1408; }
            transpose_item(W, D, ks, 32 * nb + ln, (bf16*)(F.ws + WS_WUP), 1920, kd, 32 * nb, scr, lane); continue; } r -= I_UP;
        if (r < I_OUT) { const int kb = r / (D / 32), nb = r % (D / 32);
            transpose_item(F.in[I_WOUT] + (size_t)l * D * D, D, 64 * kb, 32 * nb + ln, (bf16*)(F.ws + WS_WOUT), D, 64 * kb, 32 * nb, scr, lane); continue; } r -= I_OUT;
        if (r < I_F1) { const int kb = r / (FF2 / 32), nb = r % (FF2 / 32); const int n0 = 32 * nb, pn = n0 >> 8, j = n0 & 255;
            const float* W = (j < 128 ? F.in[I_WFFG] : F.in[I_WFFU]) + (size_t)l * D * FFH;
            transpose_item(W, FFH, 64 * kb, 128 * pn + (j & 127) + ln, (bf16*)(F.ws + WS_WFF1), D, 64 * kb, n0, scr, lane); continue; } r -= I_F1;
        if (r < I_F2) { const int kb = r / (D / 32), nb = r % (D / 32);
            transpose_item(F.in[I_WFFD] + (size_t)l * FFH * D, D, 64 * kb, 32 * nb + ln, (bf16*)(F.ws + WS_WFF2), FFH, 64 * kb, 32 * nb, scr, lane); continue; } r -= I_F2;
        { const int kb = r / (384 / 32), nb = r % (384 / 32);
            transpose_item(F.in[I_WGLU] + (size_t)l * 384 * 384, 384, 64 * kb, 32 * nb + ln, (bf16*)(F.ws + WS_WGLU), 384, 64 * kb, 32 * nb, scr, lane); }
    }
}

__device__ __forceinline__ void norm_phase(Frame& F, const float* xl, const float* xc, const float* gn, int l, int si, int nrows) {
    PHASE_IDS();
    const int gw = F.vcu * NWAVES + wave, NGW = F.G * NWAVES;
    bf16* hn = (bf16*)(F.ws + WS_HN);
    f32x4 g4[4];
#pragma unroll
    for (int j = 0; j < 4; ++j) g4[j] = ((const f32x4*)gn)[lane + 64 * j];
    for (int R0 = gw; R0 < nrows; R0 += 2 * NGW) {
        f32x4 v[2][4], sc[2][4], sh[2][4];
#pragma unroll
        for (int q = 0; q < 2; ++q) { const int R = R0 + q * NGW; if (R < nrows) { const float* xrow = R < MLAT ? xl + (size_t)R * D : xc + (size_t)(R - MLAT) * D; const f32x4* xr = (const f32x4*)xrow + lane;
                const int mb = R < MLAT ? R / SEQ : 4; const f32x4* shp = (const f32x4*)modp(F, l, mb, si) + lane; const f32x4* scp = (const f32x4*)modp(F, l, mb, si + 1) + lane;
#pragma unroll
                for (int j = 0; j < 4; ++j) { v[q][j] = xr[64 * j]; sc[q][j] = scp[64 * j]; sh[q][j] = shp[64 * j]; } } }
        __builtin_amdgcn_sched_barrier(0);
#pragma unroll
        for (int q = 0; q < 2; ++q) { const int R = R0 + q * NGW; if (R < nrows) {
            float ss = 0.f;
#pragma unroll
            for (int j = 0; j < 4; ++j) ss += (v[q][j].x * v[q][j].x + v[q][j].y * v[q][j].y) + (v[q][j].z * v[q][j].z + v[q][j].w * v[q][j].w);
            const float rstd = __builtin_amdgcn_rsqf(wave_sum(ss) * (1.f / D) + RMS_EPS);
            unsigned long long* o8 = (unsigned long long*)(hn + (size_t)R * D) + lane;
#pragma unroll
            for (int j = 0; j < 4; ++j) { const f32x4 y = v[q][j] * rstd * g4[j] * (sc[q][j] + 1.0f) + sh[q][j];
                o8[64 * j] = (unsigned long long)pk2(y.x, y.y) | ((unsigned long long)pk2(y.z, y.w) << 32); } } }
    }
}
__device__ __forceinline__ void final_norm_phase(Frame& F) {
    PHASE_IDS();
    const int gw = F.vcu * NWAVES + wave, NGW = F.G * NWAVES;
    f32x4 g4[4];
#pragma unroll
    for (int j = 0; j < 4; ++j) g4[j] = ((const f32x4*)F.in[I_GFINAL])[lane + 64 * j];
    for (int R0 = gw; R0 < MLAT; R0 += 4 * NGW) {
        f32x4 v[4][4];
#pragma unroll
        for (int q = 0; q < 4; ++q) { const int R = R0 + q * NGW; if (R < MLAT) { const f32x4* xr = (const f32x4*)(F.out + (size_t)R * D) + lane;
#pragma unroll
                for (int j = 0; j < 4; ++j) v[q][j] = xr[64 * j]; } }
#pragma unroll
        for (int q = 0; q < 4; ++q) { const int R = R0 + q * NGW; if (R < MLAT) { float ss = 0.f;
#pragma unroll
            for (int j = 0; j < 4; ++j) ss += (v[q][j].x * v[q][j].x + v[q][j].y * v[q][j].y) + (v[q][j].z * v[q][j].z + v[q][j].w * v[q][j].w);
            const float rstd = __builtin_amdgcn_rsqf(wave_sum(ss) * (1.f / D) + RMS_EPS);
            f32x4* xr = (f32x4*)(F.out + (size_t)R * D) + lane;
#pragma unroll
            for (int j = 0; j < 4; ++j) xr[64 * j] = v[q][j] * rstd * g4[j]; } }
    }
}

struct EpiResid {
    static constexpr bool PERM = false;
    const float* base_l; const float* base_c; float* out_l; float* out_c; const float* mod;
    __device__ __forceinline__ void operator()(const f32x4 (&acc)[2][2][4][2], const pg8::Unit& u, int wr, int wc, int fr, int fq) const {
        const int pmg = u.pmg; const bool isc = pmg >= 64;
        const float* base = isc ? base_c + (size_t)(pmg - 64) * 256 * D : base_l + (size_t)pmg * 256 * D;
        float* out = isc ? out_c + (size_t)(pmg - 64) * 256 * D : out_l + (size_t)pmg * 256 * D;
        const float* mv = mod + (size_t)mb_of_tile(pmg) * 6 * D;
        const int row0 = wr * 64 + fr, col0 = u.pn * 256 + wc * 32 + 4 * fq;
#pragma unroll
        for (int ai = 0; ai < 2; ++ai)
#pragma unroll
            for (int m = 0; m < 4; ++m) { const size_t off = (size_t)(row0 + ai * 128 + m * 16) * D + col0;
                f32x4 b4[2][2], mv4[2][2];
#pragma unroll
                for (int bj = 0; bj < 2; ++bj)
#pragma unroll
                    for (int n = 0; n < 2; ++n) { b4[bj][n] = *(const f32x4*)(base + off + bj * 128 + n * 16); mv4[bj][n] = *(const f32x4*)(mv + col0 + bj * 128 + n * 16); }
                __builtin_amdgcn_sched_barrier(0);
#pragma unroll
                for (int bj = 0; bj < 2; ++bj)
#pragma unroll
                    for (int n = 0; n < 2; ++n) *(f32x4*)(out + off + bj * 128 + n * 16) = b4[bj][n] + mv4[bj][n] * acc[ai][bj][m][n];
                asm volatile("" ::: "memory"); }
    }
};
struct EpiSwiglu {
    static constexpr bool PERM = true;
    bf16* H;
    __device__ __forceinline__ void operator()(const f32x4 (&acc)[2][2][4][2], const pg8::Unit& u, int wr, int wc, int fr, int fq) const {
        const int row0 = u.pmg * 256 + wr * 64 + fr, col0 = u.pn * 128 + wc * 32 + 8 * fq;
#pragma unroll
        for (int ai = 0; ai < 2; ++ai)
#pragma unroll
            for (int m = 0; m < 4; ++m) { bf16* p = H + (size_t)(row0 + ai * 128 + m * 16) * FFH + col0;
                const f32x4 g0 = acc[ai][0][m][0], g1 = acc[ai][0][m][1], u0 = acc[ai][1][m][0], u1 = acc[ai][1][m][1];
                u32x4 w; w.x = pk2(siluf_(g0[0]) * u0[0], siluf_(g0[1]) * u0[1]); w.y = pk2(siluf_(g0[2]) * u0[2], siluf_(g0[3]) * u0[3]);
                w.z = pk2(siluf_(g1[0]) * u1[0], siluf_(g1[1]) * u1[1]); w.w = pk2(siluf_(g1[2]) * u1[2], siluf_(g1[3]) * u1[3]);
                *(u32x4*)p = w; }
    }
};
struct OrderGlobal {
    const char* A; const char* B; int lda, ldb, nM, nN, nt, G, c;
    __device__ __forceinline__ bool next(int i, pg8::Unit& u) const {
        const int L = i * G + c; if (L >= nM * nN) return false;
        int pm, pn; pg8::tile_of(L, nM, nN, pm, pn);
        u.pm = pm; u.pn = pn; u.pmg = pm; u.br = 0; u.nt = nt;
        u.A = A + (size_t)pm * 256 * lda * 2; u.B = B + (size_t)pn * 256 * ldb * 2; return true;
    }
};


constexpr int ZC_Q = 0, ZC_K = 512, ZC_V = 1024, ZC_U = 1536, ZC_G = 1920, ZC_O = 2048, ZC_SU = 2560, ZC_SV = 3072, ZC_CB = 3584, ZC_CC = 4096, ZC_CX = 4608, ZC_BG = 5120;
constexpr int LDT = 136;
constexpr int NLC = 68;
constexpr size_t MS_NST = 0, MS_SC = 512 * 1024, MS_S5X = 1 * MiB;
constexpr size_t S5T_AB = 0, S5T_BB = 73728, S5T_CC = S5T_BB + 2 * 24 * 8 * 64 * 16;
__device__ __forceinline__ float geluf_(float x) { const float z = 1.5957691216f * (x + 0.044715f * x * x * x); return x * rcpf_(1.0f + __expf(-z)); }
__device__ __forceinline__ float logsigf_(float f) { return fminf(f, 0.f) - log1pf(__expf(-fabsf(f))); }
__device__ __forceinline__ int gtile_of(int g, int pm_l) { return pm_l < 32 ? g * 32 + pm_l : 64 + g * 2 + (pm_l - 32); }
__device__ __forceinline__ float bflo(unsigned w) { return __builtin_bit_cast(float, w << 16); }
__device__ __forceinline__ float bfhi(unsigned w) { return __builtin_bit_cast(float, w & 0xffff0000u); }
__device__ __forceinline__ int chain_lc(int b, int dir, int k) { return k < 2 ? 64 + 2 * b + (dir ? 1 - k : k) : 32 * b + (dir ? 31 - (k - 2) : (k - 2)); }

template <int NT, int KS>
__device__ __forceinline__ void mm_lds(f32x4 (&acc)[NT], const LAS bf16* A, int lda, const LAS bf16* BT, int ldb, int bclamp, int lane) {
    const int r = lane & 15, kq = lane >> 4;
#pragma unroll
    for (int ks = 0; ks < KS; ++ks) {
        const bf16x8 a = *(const LAS bf16x8*)(A + r * lda + ks * 32 + kq * 8);
        bf16x8 b[NT];
#pragma unroll
        for (int n = 0; n < NT; ++n) { int br = n * 16 + r; br = br > bclamp ? bclamp : br; b[n] = *(const LAS bf16x8*)(BT + br * ldb + ks * 32 + kq * 8); }
#pragma unroll
        for (int n = 0; n < NT; ++n) acc[n] = __builtin_amdgcn_mfma_f32_16x16x32_bf16(a, b[n], acc[n], 0, 0, 0);
    }
}
typedef short v4i16_t __attribute__((ext_vector_type(4)));
__device__ __forceinline__ bf16x8 frag_tr(const LAS bf16* T, int ld, int k0, int n0, int lane) {
    const int g = lane >> 4, q = (lane & 15) >> 2, p = lane & 3;
    const LAS bf16* a = T + (k0 + 8 * g + q) * ld + n0 + 4 * p;
    const v4i16_t lo = __builtin_amdgcn_ds_read_tr16_b64_v4i16((LAS v4i16_t*)a);
    const v4i16_t hi = __builtin_amdgcn_ds_read_tr16_b64_v4i16((LAS v4i16_t*)(a + 4 * ld));
    return (bf16x8){lo[0], lo[1], lo[2], lo[3], hi[0], hi[1], hi[2], hi[3]};
}
template <int NT, int KS>
__device__ __forceinline__ void mm_nn(f32x4 (&acc)[NT], const LAS bf16* A, int lda, const LAS bf16* B, int ldb, int lane) {
    const int r = lane & 15, kq = lane >> 4;
#pragma unroll
    for (int ks = 0; ks < KS; ++ks) {
        const bf16x8 a = *(const LAS bf16x8*)(A + r * lda + ks * 32 + kq * 8);
        bf16x8 b[NT];
#pragma unroll
        for (int n = 0; n < NT; ++n) b[n] = frag_tr(B, ldb, ks * 32, n * 16, lane);
#pragma unroll
        for (int n = 0; n < NT; ++n) acc[n] = __builtin_amdgcn_mfma_f32_16x16x32_bf16(a, b[n], acc[n], 0, 0, 0);
    }
}
__device__ __forceinline__ void scan_max2(float a, float b, int lane, float& m0, float& m1) {
    float s = fmaxf(a, b);
#pragma unroll
    for (int o = 1; o < 64; o <<= 1) { const float t = __shfl_up(s, o); if (lane >= o) s = fmaxf(s, t); }
    float ex = __shfl_up(s, 1); if (lane == 0) ex = -INFINITY;
    m0 = fmaxf(ex, a); m1 = s;
}
__device__ __forceinline__ float grp16_max(float v) { v = fmaxf(v, __shfl_xor(v, 1)); v = fmaxf(v, __shfl_xor(v, 2)); v = fmaxf(v, __shfl_xor(v, 4)); v = fmaxf(v, __shfl_xor(v, 8)); return v; }
__device__ __forceinline__ float grp16_sum(float v) { v += __shfl_xor(v, 1); v += __shfl_xor(v, 2); v += __shfl_xor(v, 4); v += __shfl_xor(v, 8); return v; }

__device__ __forceinline__ void mlstm_gates(Frame& F, int l, const bf16* zx, int lc, int h, int d, int p, float& lf, float& ip) {
    const bf16* row = zx + (size_t)(lc * 128 + p) * ZW + ZC_G; const float* bg = F.in[I_BGATES] + l * 16;
    ip = bf2f(row[(2 * d) * 4 + h]) + bg[(2 * d) * 4 + h];
    lf = logsigf_(bf2f(row[(2 * d + 1) * 4 + h]) + bg[(2 * d + 1) * 4 + h]);
}
__device__ __forceinline__ float mlstm_scan128(LAS float* cum, int d, int lane, float& c0, float& c1, int& i0, int& i1) {
    i0 = d ? 127 - 2 * lane : 2 * lane; i1 = d ? 126 - 2 * lane : 2 * lane + 1;
    const float a = cum[i0], b = cum[i1]; float s = a + b;
#pragma unroll
    for (int o = 1; o < 64; o <<= 1) { const float t = __shfl_up(s, o); if (lane >= o) s += t; }
    c1 = s; c0 = s - b; cum[i0] = c0; cum[i1] = c1;
    return __shfl(s, 63);
}
__device__ __forceinline__ void qk_conv2(const bf16* zx, const float* wc  , int lr, int col, bool hl, bool hr, float& y0, float& y1) {
    const unsigned c = *(const unsigned*)(zx + (size_t)lr * ZW + col);
    const unsigned a = hl ? *(const unsigned*)(zx + (size_t)(lr - 1) * ZW + col) : 0u;
    const unsigned b = hr ? *(const unsigned*)(zx + (size_t)(lr + 1) * ZW + col) : 0u;
    const int ch = col & 511;
    y0 = siluf_(wc[ch] * bflo(a) + wc[512 + ch] * bflo(c) + wc[1024 + ch] * bflo(b));
    y1 = siluf_(wc[ch + 1] * bfhi(a) + wc[512 + ch + 1] * bfhi(c) + wc[1024 + ch + 1] * bfhi(b));
}
__device__ __forceinline__ void nbr_flags(int lc, int s, bool& hl, bool& hr) {
    if (lc < 64) { hl = (s & 63) != 0; hr = (s & 63) != 63; } else { const int t = ((lc - 64) & 1) * 128 + s; hl = t != 0; hr = t != 255; }
}

__device__ __forceinline__ void qk_conv8(const u32x4 a, const u32x4 c, const u32x4 b, const float* w  , float scale, u32x4& o) {
    float y[8];
#pragma unroll
    for (int e = 0; e < 4; ++e) {
        y[2 * e] = siluf_(w[2 * e] * bflo(a[e]) + w[8 + 2 * e] * bflo(c[e]) + w[16 + 2 * e] * bflo(b[e])) * scale;
        y[2 * e + 1] = siluf_(w[2 * e + 1] * bfhi(a[e]) + w[8 + 2 * e + 1] * bfhi(c[e]) + w[16 + 2 * e + 1] * bfhi(b[e])) * scale; }
    o = (u32x4){pk2(y[0], y[1]), pk2(y[2], y[3]), pk2(y[4], y[5]), pk2(y[6], y[7])};
}
__device__ __forceinline__ void qk_conv_rows(const bf16* zx, const float* wc, int lc, int rg, int colb, int ch0, float scale, u32x4 (&out)[4]) {
    float w[24];
#pragma unroll
    for (int j = 0; j < 3; ++j) { const f32x4 w0 = *(const f32x4*)(wc + j * 512 + ch0), w1 = *(const f32x4*)(wc + j * 512 + ch0 + 4);
#pragma unroll
        for (int e = 0; e < 4; ++e) { w[j * 8 + e] = w0[e]; w[j * 8 + 4 + e] = w1[e]; } }
    const int s0 = 4 * rg; bool hl, hr, d0, d1; nbr_flags(lc, s0, hl, d0); nbr_flags(lc, s0 + 3, d1, hr);
    const bf16* p = zx + (size_t)(lc * 128 + s0) * ZW + colb + ch0;
    u32x4 r[6];
    const u32x4 zz = zero4();
    r[0] = hl ? *(const u32x4*)(p - ZW) : zz;
#pragma unroll
    for (int i = 0; i < 4; ++i) r[1 + i] = *(const u32x4*)(p + (size_t)i * ZW);
    r[5] = hr ? *(const u32x4*)(p + (size_t)4 * ZW) : zz;
#pragma unroll
    for (int i = 0; i < 4; ++i) qk_conv8(r[i], r[i + 1], r[i + 2], w, scale, out[i]);
}
__device__ __forceinline__ void mlstm_local_item(Frame& F, int l, int lc, int h) {
    PHASE_IDS();
    bf16* zx = (bf16*)(F.ws + WS_ZX);
    LAS bf16* KP = (LAS bf16*)F.lds; LAS bf16* VF = KP + 128 * LDT; LAS bf16* VB = VF + 128 * LDT;
    LAS float* lfc = (LAS float*)(F.lds + 104448); LAS float* ipa = lfc + 256; LAS float* wa = ipa + 256;
    LAS bf16* wh = (LAS bf16*)(wa + 256);
    float* SCb = (float*)(F.ws + WS_MISC + MS_SC);
    __syncthreads();
    if (tid < 256) { const int d = tid >> 7, p = tid & 127; float lf, ip; mlstm_gates(F, l, zx, lc, h, d, p, lf, ip); lfc[tid] = lf; ipa[tid] = ip; }
    __syncthreads();
    if (wave < 2) { const int d = wave;
        float c0, c1; int i0, i1; const float tot = mlstm_scan128(lfc + d * 128, d, lane, c0, c1, i0, i1);
        const float l0 = tot - c0 + ipa[d * 128 + i0], l1 = tot - c1 + ipa[d * 128 + i1];
        float m = fmaxf(l0, l1);
#pragma unroll
        for (int o = 1; o < 64; o <<= 1) m = fmaxf(m, __shfl_xor(m, o));
        const float w0 = __expf(l0 - m), w1 = __expf(l1 - m);
        wa[d * 128 + i0] = w0; wa[d * 128 + i1] = w1; wh[d * 128 + i0] = (bf16)f2bf(w0); wh[d * 128 + i1] = (bf16)f2bf(w1);
        if (lane == 0) { float* SC = SCb + ((lc * 4 + h) * 2 + d) * 4; SC[0] = m; SC[1] = tot; }
    }
    const int rg = tid >> 4, ch0 = (tid & 15) * 8;
    const float* wcq = F.in[I_WCONVQK] + (size_t)(l * 2) * 3 * 512 + h * 128; const float* wck = wcq + 3 * 512;
    u32x4 qo[4], ko[4], vv[4];
    qk_conv_rows(zx, wcq, lc, rg, ZC_Q + h * 128, ch0, 1.0f, qo);
    qk_conv_rows(zx, wck, lc, rg, ZC_K + h * 128, ch0, 0.08838834764831845f, ko);
#pragma unroll
    for (int i = 0; i < 4; ++i) vv[i] = *(const u32x4*)(zx + (size_t)(lc * 128 + 4 * rg + i) * ZW + ZC_V + h * 128 + ch0);
    __syncthreads();
#pragma unroll
    for (int i = 0; i < 4; ++i) { const int s = 4 * rg + i;
        *(LAS u32x4*)(KP + s * LDT + ch0) = ko[i];
        const float wf = wa[s], wb = wa[128 + s]; u32x4 f, b;
#pragma unroll
        for (int e = 0; e < 4; ++e) { const float lo = bflo(vv[i][e]), hi = bfhi(vv[i][e]); f[e] = pk2(lo * wf, hi * wf); b[e] = pk2(lo * wb, hi * wb); }
        *(LAS u32x4*)(VF + s * LDT + ch0) = f; *(LAS u32x4*)(VB + s * LDT + ch0) = b;
        if (lc < 64) { bf16* zr = zx + (size_t)(lc * 128 + s) * ZW + h * 128 + ch0; *(u32x4*)(zr + ZC_Q) = qo[i]; *(u32x4*)(zr + ZC_K) = ko[i]; } }
    __syncthreads();
    f32x4 accf[9], accb[9];
#pragma unroll
    for (int n = 0; n < 9; ++n) { accf[n] = (f32x4){0.f, 0.f, 0.f, 0.f}; accb[n] = (f32x4){0.f, 0.f, 0.f, 0.f}; }
#pragma unroll
    for (int ks = 0; ks < 4; ++ks) {
        const bf16x8 a = frag_tr(KP, LDT, ks * 32, wave * 16, lane);
        const bf16x8 wfv = *(const LAS bf16x8*)(wh + ks * 32 + (lane >> 4) * 8), wbv = *(const LAS bf16x8*)(wh + 128 + ks * 32 + (lane >> 4) * 8);
        { bf16x8 bfr[8];
#pragma unroll
            for (int n = 0; n < 8; ++n) bfr[n] = frag_tr(VF, LDT, ks * 32, n * 16, lane);
#pragma unroll
            for (int n = 0; n < 8; ++n) accf[n] = __builtin_amdgcn_mfma_f32_16x16x32_bf16(a, bfr[n], accf[n], 0, 0, 0);
#pragma unroll
            for (int n = 0; n < 8; ++n) bfr[n] = frag_tr(VB, LDT, ks * 32, n * 16, lane);
#pragma unroll
            for (int n = 0; n < 8; ++n) accb[n] = __builtin_amdgcn_mfma_f32_16x16x32_bf16(a, bfr[n], accb[n], 0, 0, 0); }
        accf[8] = __builtin_amdgcn_mfma_f32_16x16x32_bf16(a, wfv, accf[8], 0, 0, 0); accb[8] = __builtin_amdgcn_mfma_f32_16x16x32_bf16(a, wbv, accb[8], 0, 0, 0);
    }
    const int r0 = wave * 16 + (lane >> 4) * 4, cc = lane & 15;
    __syncthreads();
#pragma unroll
    for (int n = 0; n < 8; ++n)
#pragma unroll
        for (int i = 0; i < 4; ++i) { KP[(r0 + i) * LDT + n * 16 + cc] = (bf16)f2bf(accf[n][i]); VF[(r0 + i) * LDT + n * 16 + cc] = (bf16)f2bf(accb[n][i]); }
    if (cc == 0) {
#pragma unroll
        for (int d = 0; d < 2; ++d) { float* NST = (float*)(F.ws + WS_MISC + MS_NST) + ((lc * 4 + h) * 2 + d) * 128;
#pragma unroll
            for (int i = 0; i < 4; ++i) NST[r0 + i] = d ? accb[8][i] : accf[8][i]; } }
    __syncthreads();
#pragma unroll
    for (int q = 0; q < 8; ++q) { const int idx = q * 512 + tid, d = idx >> 11, r = (idx >> 4) & 127, e0 = (idx & 15) * 8;
        bf16* MST = (bf16*)(F.ws + WS_MST) + (size_t)((lc * 4 + h) * 2 + d) * 16384;
        *(u32x4*)(MST + r * 128 + e0) = *(const LAS u32x4*)((d ? VF : KP) + r * LDT + e0); }
}

__device__ __forceinline__ void cmul(float& xr, float& xi, float ar, float ai) { const float r = ar * xr - ai * xi, i = ar * xi + ai * xr; xr = r; xi = i; }
__device__ __forceinline__ void s5_tables(Frame& F, int l) {
    PHASE_IDS();
    unsigned char* T = F.ws + WS_S5T;
    for (int idx = F.vcu * NTHR + tid; idx < 2 * 24 * 64; idx += F.G * NTHR) {
        const int dir = idx / 1536, g5 = (idx % 1536) >> 6, p = idx & 63;
        const int ix = ((l * 2 + dir) * 24 + g5) * 64 + p;
        const float are = F.in[I_S5ARE][ix], aim = F.in[I_S5AIM][ix];
        const float dt = __expf(F.in[I_S5LOGDT][(l * 2 + dir) * 24 + g5]);
        const float mag = __expf(dt * are); float rev = dt * aim * 0.15915494309189535f; rev -= floorf(rev);
        const float ab_re = mag * __builtin_amdgcn_cosf(rev), ab_im = mag * __builtin_amdgcn_sinf(rev);
        float pr = ab_re, pi = ab_im;
#pragma unroll
        for (int q = 0; q < 5; ++q) { const float r = pr * pr - pi * pi, i = 2.f * pr * pi; pr = r; pi = i; }
        const float a32r = pr, a32i = pi;
#pragma unroll
        for (int q = 0; q < 2; ++q) { const float r = pr * pr - pi * pi, i = 2.f * pr * pi; pr = r; pi = i; }
        float* ab = (float*)(T + S5T_AB) + (size_t)idx * 6;
        ab[0] = ab_re; ab[1] = ab_im; ab[2] = a32r; ab[3] = a32i; ab[4] = pr; ab[5] = pi;
        const float nr = ab_re - 1.0f, ni = ab_im, den = rcpf_(are * are + aim * aim);
        const float f_re = (nr * are + ni * aim) * den, f_im = (ni * are - nr * aim) * den;
        const f32x4* br = (const f32x4*)(F.in[I_S5BRE] + ((size_t)(l * 24 + g5) * 64 + p) * 16); const f32x4* bi = (const f32x4*)(F.in[I_S5BIM] + ((size_t)(l * 24 + g5) * 64 + p) * 16);
        float bbr[16], bbi[16];
#pragma unroll
        for (int q = 0; q < 4; ++q) { const f32x4 r = br[q], i = bi[q];
#pragma unroll
            for (int e = 0; e < 4; ++e) { bbr[q * 4 + e] = f_re * r[e] - f_im * i[e]; bbi[q * 4 + e] = f_re * i[e] + f_im * r[e]; } }
        u32x4* bb = (u32x4*)(T + S5T_BB) + (size_t)(dir * 24 + g5) * 8 * 64;
        const int pt = p >> 3, cc = (2 * p) & 15;
#pragma unroll
        for (int g = 0; g < 4; ++g) {
            u32x4 vr = (u32x4){0u, 0u, 0u, 0u}, vi = vr;
            if (g < 2) { vr = (u32x4){pk2(bbr[8 * g], bbr[8 * g + 1]), pk2(bbr[8 * g + 2], bbr[8 * g + 3]), pk2(bbr[8 * g + 4], bbr[8 * g + 5]), pk2(bbr[8 * g + 6], bbr[8 * g + 7])};
                         vi = (u32x4){pk2(bbi[8 * g], bbi[8 * g + 1]), pk2(bbi[8 * g + 2], bbi[8 * g + 3]), pk2(bbi[8 * g + 4], bbi[8 * g + 5]), pk2(bbi[8 * g + 6], bbi[8 * g + 7])}; }
            bb[pt * 64 + g * 16 + cc] = vr; bb[pt * 64 + g * 16 + cc + 1] = vi; }
    }
    for (int idx = F.vcu * NTHR + tid; idx < 24 * 4 * 64; idx += F.G * NTHR) {
        const int g5 = idx >> 8, ks = (idx >> 6) & 3, ln = idx & 63, j = ln & 15, k = ks * 32 + (ln >> 4) * 8, p0 = k >> 1;
        const f32x4 cr = *(const f32x4*)(F.in[I_S5CRE] + ((size_t)(l * 24 + g5) * 16 + j) * 64 + p0), ci = *(const f32x4*)(F.in[I_S5CIM] + ((size_t)(l * 24 + g5) * 16 + j) * 64 + p0);
        ((u32x4*)(T + S5T_CC))[idx] = (u32x4){pk2(cr[0], -ci[0]), pk2(cr[1], -ci[1]), pk2(cr[2], -ci[2]), pk2(cr[3], -ci[3])};
    }
}
__device__ __forceinline__ void s5_drive32(const u32x4* bbf  , const LAS bf16* U16, LAS bf16* BU, int lane) {
    const bf16x8 b0 = *(const LAS bf16x8*)(U16 + (lane & 15) * 32 + (lane >> 4) * 8), b1 = *(const LAS bf16x8*)(U16 + (16 + (lane & 15)) * 32 + (lane >> 4) * 8);
#pragma unroll
    for (int pt = 0; pt < 8; ++pt) {
        const bf16x8 a = __builtin_bit_cast(bf16x8, bbf[pt * 64 + lane]);
        const f32x4 z = (f32x4){0.f, 0.f, 0.f, 0.f};
        const f32x4 o0 = __builtin_amdgcn_mfma_f32_16x16x32_bf16(a, b0, z, 0, 0, 0), o1 = __builtin_amdgcn_mfma_f32_16x16x32_bf16(a, b1, z, 0, 0, 0);
        *(LAS u32x2*)(BU + (lane & 15) * LDT + pt * 16 + (lane >> 4) * 4) = (u32x2){pk2(o0[0], o0[1]), pk2(o0[2], o0[3])};
        *(LAS u32x2*)(BU + (16 + (lane & 15)) * LDT + pt * 16 + (lane >> 4) * 4) = (u32x2){pk2(o1[0], o1[1]), pk2(o1[2], o1[3])};
    }
}
__device__ __forceinline__ void s5_local_item(Frame& F, int l, int lc, int sub) {
    PHASE_IDS();
    const bf16* zx = (const bf16*)(F.ws + WS_ZX);
    const int wt = sub * 8 + wave, g5 = wt >> 1, dir = wt & 1, p = lane;
    LAS bf16* U16 = (LAS bf16*)(F.lds + wave * 16896); LAS bf16* BU = U16 + 128 * 32;
    __syncthreads();
    const float* abp = (const float*)(F.ws + WS_S5T + S5T_AB) + (size_t)((dir * 24 + g5) * 64 + p) * 6;
    const float ab_re = abp[0], ab_im = abp[1];
    const u32x4* bbf = (const u32x4*)(F.ws + WS_S5T + S5T_BB) + (size_t)(dir * 24 + g5) * 8 * 64;
    { u32x4 uu[4];
#pragma unroll
        for (int i = 0; i < 4; ++i) { const int c = i * 64 + lane, t = c >> 1, h8 = (c & 1) * 8; uu[i] = *(const u32x4*)(zx + (size_t)(lc * 128 + t) * ZW + ZC_U + g5 * 16 + h8); }
        const u32x4 z4 = zero4();
#pragma unroll
        for (int i = 0; i < 4; ++i) { const int c = i * 64 + lane, t = c >> 1, h8 = (c & 1) * 8; *(LAS u32x4*)(U16 + t * 32 + h8) = uu[i]; *(LAS u32x4*)(U16 + t * 32 + 16 + h8) = z4; } }
    LDS_WAIT(); asm volatile("" ::: "memory");
    float xr = 0.f, xi = 0.f;
    f32x2* E = (f32x2*)(F.ws + WS_S5E);
#pragma unroll 1
    for (int qq = 0; qq < 4; ++qq) {
        const int q = dir ? 3 - qq : qq;
        s5_drive32(bbf, U16 + q * 32 * 32, BU, lane);
        LDS_WAIT(); asm volatile("" ::: "memory");
        unsigned wv[32];
#pragma unroll
        for (int k = 0; k < 32; ++k) { const int tl = dir ? 31 - k : k; wv[k] = *(const LAS unsigned*)(BU + tl * LDT + 2 * p); }
#pragma unroll
        for (int k = 0; k < 32; ++k) { const float bur = bflo(wv[k]), bui = bfhi(wv[k]);
            const float nr = ab_re * xr - ab_im * xi + bur, ni = ab_re * xi + ab_im * xr + bui; xr = nr; xi = ni; }
        E[((size_t)((lc * 2 + dir) * 4 + qq) * 24 + g5) * 64 + p] = (f32x2){xr, xi};
        LDS_WAIT(); asm volatile("" ::: "memory");
    }
}

__device__ __forceinline__ void scan_phase(Frame& F, int l) {
    PHASE_IDS();
    float* SCb = (float*)(F.ws + WS_MISC + MS_SC);
    for (int w = F.vcu; w < 256; w += F.G) {
        const int chain = w >> 4, blk = w & 15, b = chain >> 3, h = (chain >> 1) & 3, d = chain & 1;
        bf16* MSTb = (bf16*)(F.ws + WS_MST) + blk * 1024 + tid * 2;
        f32x2 v[34], sv[34];
#pragma unroll
        for (int k = 0; k < 34; ++k) { const int it = (chain_lc(b, d, k) * 4 + h) * 2 + d; const unsigned w2 = *(const unsigned*)(MSTb + (size_t)it * 16384); v[k] = (f32x2){bflo(w2), bfhi(w2)}; sv[k] = *(const f32x2*)(SCb + it * 4); }
        float zf = 0.f; asm volatile("" : "+v"(zf));
        float m = 0.f; f32x2 carry = (f32x2){zf, zf};
#pragma unroll
        for (int k = 0; k < 34; ++k) { const int it = (chain_lc(b, d, k) * 4 + h) * 2 + d;
            const float ml = sv[k].x, bl = sv[k].y, mn = fmaxf(bl + m, ml), dec = __expf(bl + m - mn), sc = __expf(ml - mn);
            *(unsigned*)(MSTb + (size_t)it * 16384) = pk2(carry.x, carry.y); carry = carry * dec + v[k] * sc;
            if (blk == 0 && tid == 0) SCb[it * 4 + 2] = m;
            m = mn; }
        if (blk == 1 && tid < 128) {
            float* NSTb = (float*)(F.ws + WS_MISC + MS_NST) + tid; float nv[34]; f32x2 sn[34];
#pragma unroll
            for (int k = 0; k < 34; ++k) { const int it = (chain_lc(b, d, k) * 4 + h) * 2 + d; nv[k] = NSTb[it * 128]; sn[k] = *(const f32x2*)(SCb + it * 4); }
            float mm = 0.f, cn = 0.f; asm volatile("" : "+v"(cn));
#pragma unroll
            for (int k = 0; k < 34; ++k) { const int it = (chain_lc(b, d, k) * 4 + h) * 2 + d;
                const float ml = sn[k].x, bl = sn[k].y, mn = fmaxf(bl + mm, ml), dec = __expf(bl + mm - mn), sc = __expf(ml - mn);
                NSTb[it * 128] = cn; cn = cn * dec + nv[k] * sc; mm = mn; }
        }
    }
    for (int w = F.vcu; w < 12; w += F.G) {
        const int gid = w * 512 + tid, b = gid / 3072, rem = gid % 3072, dir = rem / 1536, g5 = (rem % 1536) >> 6, p = rem & 63;
        const float* abp = (const float*)(F.ws + WS_S5T + S5T_AB) + (size_t)((dir * 24 + g5) * 64 + p) * 6; const float ar = abp[4], ai = abp[5];
        const f32x2* E = (const f32x2*)(F.ws + WS_S5E); f32x2* X = (f32x2*)(F.ws + WS_MISC + MS_S5X);
        f32x2 e[34];
#pragma unroll
        for (int k = 0; k < 34; ++k) { const int lc = chain_lc(b, dir, k); e[k] = E[((size_t)((lc * 2 + dir) * 4 + 3) * 24 + g5) * 64 + p]; }
        float xr = 0.f; asm volatile("" : "+v"(xr)); float xi = xr;
#pragma unroll
        for (int k = 0; k < 34; ++k) { const int lc = chain_lc(b, dir, k); X[((size_t)(lc * 2 + dir) * 24 + g5) * 64 + p] = (f32x2){xr, xi};
            cmul(xr, xi, ar, ai); xr += e[k].x; xi += e[k].y; }
    }
}

__device__ __forceinline__ void mlstm_out_item(Frame& F, int l, int lc, int h) {
    PHASE_IDS();
    bf16* zx = (bf16*)(F.ws + WS_ZX);
    LAS bf16* Q = (LAS bf16*)F.lds; LAS bf16* KS = Q + 128 * LDT; LAS bf16* V = KS + 128 * LDT; LAS bf16* C = V + 128 * LDT;
    LAS float* gs = (LAS float*)(F.lds + 139264); LAS float* mm = gs + 256; LAS float* mt = mm + 256;
    LAS bf16* nv = (LAS bf16*)(mt + 256);
    const float* SCb = (const float*)(F.ws + WS_MISC + MS_SC);
    __syncthreads();
    if (tid < 256) { const int d = tid >> 7, p = tid & 127; float lf, ip; mlstm_gates(F, l, zx, lc, h, d, p, lf, ip); gs[tid] = lf; mm[tid] = ip; }
    { const int rg = tid >> 4, ch0 = (tid & 15) * 8; u32x4 qo[4], ko[4], vv[4];
        if (lc < 64) {
#pragma unroll
            for (int i = 0; i < 4; ++i) { const bf16* zr = zx + (size_t)(lc * 128 + 4 * rg + i) * ZW + h * 128 + ch0; qo[i] = *(const u32x4*)(zr + ZC_Q); ko[i] = *(const u32x4*)(zr + ZC_K); }
        } else {
            const float* wcq = F.in[I_WCONVQK] + (size_t)(l * 2) * 3 * 512 + h * 128; const float* wck = wcq + 3 * 512;
            qk_conv_rows(zx, wcq, lc, rg, ZC_Q + h * 128, ch0, 1.0f, qo); qk_conv_rows(zx, wck, lc, rg, ZC_K + h * 128, ch0, 0.08838834764831845f, ko);
        }
#pragma unroll
        for (int i = 0; i < 4; ++i) vv[i] = *(const u32x4*)(zx + (size_t)(lc * 128 + 4 * rg + i) * ZW + ZC_V + h * 128 + ch0);
#pragma unroll
        for (int i = 0; i < 4; ++i) { const int s_ = 4 * rg + i; *(LAS u32x4*)(Q + s_ * LDT + ch0) = qo[i]; *(LAS u32x4*)(KS + s_ * LDT + ch0) = ko[i]; *(LAS u32x4*)(V + s_ * LDT + ch0) = vv[i]; } }
    __syncthreads();
    if (wave < 2) { const int d = wave; LAS float* gd = gs + d * 128; LAS float* md = mm + d * 128; LAS float* td = mt + d * 128;
        float c0, c1; int i0, i1; (void)mlstm_scan128(gd, d, lane, c0, c1, i0, i1);
        const float g0 = md[i0] - c0, g1 = md[i1] - c1; float p0, p1; scan_max2(g0, g1, lane, p0, p1);
        const float m_in = SCb[((lc * 4 + h) * 2 + d) * 4 + 2];
        const float mm0 = fmaxf(m_in, p0), mm1 = fmaxf(m_in, p1);
        gd[i0] = g0; gd[i1] = g1; md[i0] = mm0; md[i1] = mm1; td[i0] = c0 + mm0; td[i1] = c1 + mm1; }
    f32x4 sraw[8];
#pragma unroll
    for (int n = 0; n < 8; ++n) sraw[n] = (f32x4){0.f, 0.f, 0.f, 0.f};
    mm_lds<8, 4>(sraw, KS + (wave * 16) * LDT, LDT, Q, LDT, 127, lane);
    __syncthreads();
    f32x4 hs[8];
#pragma unroll
    for (int n = 0; n < 8; ++n) hs[n] = (f32x4){0.f, 0.f, 0.f, 0.f};
    const int r0 = wave * 16 + (lane >> 4) * 4, cc = lane & 15;
#pragma unroll 1
    for (int dir = 0; dir < 2; ++dir) {
        const int it = (lc * 4 + h) * 2 + dir;
        const float m_in = SCb[it * 4 + 2];
        {
            const bf16* MST = (const bf16*)(F.ws + WS_MST) + (size_t)it * 16384;
            u32x4 c4[4];
#pragma unroll
            for (int q = 0; q < 4; ++q) { const int idx = q * 512 + tid; c4[q] = *(const u32x4*)(MST + (idx >> 4) * 128 + (idx & 15) * 8); }
#pragma unroll
            for (int q = 0; q < 4; ++q) { const int idx = q * 512 + tid, dd = idx >> 4, e0 = (idx & 15) * 8; *(LAS u32x4*)(C + dd * LDT + e0) = c4[q]; }
            if (tid < 128) nv[tid] = (bf16)f2bf(((const float*)(F.ws + WS_MISC + MS_NST))[it * 128 + tid]);
        }
        const LAS float* gd = gs + dir * 128; const LAS float* md = mm + dir * 128; const LAS float* td = mt + dir * 128;
        {
            float g4[4];
#pragma unroll
            for (int i = 0; i < 4; ++i) g4[i] = gd[r0 + i];
            float mmv[8];
#pragma unroll
            for (int n = 0; n < 8; ++n) mmv[n] = md[n * 16 + cc];
#pragma unroll
            for (int n = 0; n < 8; ++n) { const int t = n * 16 + cc; const float mmt = mmv[n]; float v[4];
#pragma unroll
                for (int i = 0; i < 4; ++i) { const int s_ = r0 + i; const bool ok = dir ? (s_ >= t) : (s_ <= t); v[i] = ok ? sraw[n][i] * __expf(g4[i] - mmt) : 0.f; }
                *(LAS u32x2*)(KS + t * LDT + r0) = (u32x2){pk2(v[0], v[1]), pk2(v[2], v[3])}; } }
        __syncthreads();
        f32x4 ao[8], den = (f32x4){0.f, 0.f, 0.f, 0.f};
#pragma unroll
        for (int n = 0; n < 8; ++n) ao[n] = (f32x4){0.f, 0.f, 0.f, 0.f};
        const LAS bf16* Aq = Q + (wave * 16) * LDT; const LAS bf16* As = KS + (wave * 16) * LDT;
#pragma unroll
        for (int ks = 0; ks < 4; ++ks) { const bf16x8 a = *(const LAS bf16x8*)(Aq + (lane & 15) * LDT + ks * 32 + (lane >> 4) * 8);
            den = __builtin_amdgcn_mfma_f32_16x16x32_bf16(a, *(const LAS bf16x8*)(nv + ks * 32 + (lane >> 4) * 8), den, 0, 0, 0);
            bf16x8 bfr[8];
#pragma unroll
            for (int n = 0; n < 8; ++n) bfr[n] = frag_tr(C, LDT, ks * 32, n * 16, lane);
#pragma unroll
            for (int n = 0; n < 8; ++n) ao[n] = __builtin_amdgcn_mfma_f32_16x16x32_bf16(a, bfr[n], ao[n], 0, 0, 0); }
        float inter[4], emt[4];
#pragma unroll
        for (int i = 0; i < 4; ++i) { inter[i] = __expf(m_in - md[r0 + i]); emt[i] = __expf(-td[r0 + i]); den[i] *= inter[i]; }
#pragma unroll
        for (int n = 0; n < 8; ++n)
#pragma unroll
            for (int i = 0; i < 4; ++i) ao[n][i] *= inter[i];
        const bf16x8 ones = (bf16x8){0x3F80, 0x3F80, 0x3F80, 0x3F80, 0x3F80, 0x3F80, 0x3F80, 0x3F80};
#pragma unroll
        for (int ks = 0; ks < 4; ++ks) { const bf16x8 a = *(const LAS bf16x8*)(As + (lane & 15) * LDT + ks * 32 + (lane >> 4) * 8);
            den = __builtin_amdgcn_mfma_f32_16x16x32_bf16(a, ones, den, 0, 0, 0);
            bf16x8 bfr[8];
#pragma unroll
            for (int n = 0; n < 8; ++n) bfr[n] = frag_tr(V, LDT, ks * 32, n * 16, lane);
#pragma unroll
            for (int n = 0; n < 8; ++n) ao[n] = __builtin_amdgcn_mfma_f32_16x16x32_bf16(a, bfr[n], ao[n], 0, 0, 0); }
#pragma unroll
        for (int i = 0; i < 4; ++i) { const float nr = rcpf_(fmaxf(fabsf(den[i]), emt[i]));
#pragma unroll
            for (int n = 0; n < 8; ++n) hs[n][i] += ao[n][i] * nr; }
        __syncthreads();
    }
    const float* gm = F.in[I_GMH] + l * 512 + h * 128;
    float gmv[8];
#pragma unroll
    for (int n = 0; n < 8; ++n) gmv[n] = gm[n * 16 + cc];
#pragma unroll
    for (int i = 0; i < 4; ++i) { float ss = 0.f;
#pragma unroll
        for (int n = 0; n < 8; ++n) ss += hs[n][i] * hs[n][i];
        const float rstd = __builtin_amdgcn_rsqf(grp16_sum(ss) * (1.0f / 128.0f) + RMS_EPS);
#pragma unroll
        for (int n = 0; n < 8; ++n) Q[(r0 + i) * LDT + n * 16 + cc] = (bf16)f2bf(hs[n][i] * rstd * gmv[n]); }
    __syncthreads();
    u32x4 opre[4];
#pragma unroll
    for (int q = 0; q < 4; ++q) { const int idx = q * 512 + tid; opre[q] = *(const u32x4*)(zx + (size_t)(lc * 128 + (idx >> 4)) * ZW + ZC_O + h * 128 + (idx & 15) * 8); }
#pragma unroll
    for (int q = 0; q < 4; ++q) { const int idx = q * 512 + tid, t = idx >> 4, e0 = (idx & 15) * 8;
        bf16* orow = zx + (size_t)(lc * 128 + t) * ZW + ZC_O + h * 128 + e0;
        const u32x4 o4 = opre[q], h4 = *(const LAS u32x4*)(Q + t * LDT + e0); u32x4 y;
#pragma unroll
        for (int e = 0; e < 4; ++e) y[e] = pk2(bflo(h4[e]) * bflo(o4[e]), bfhi(h4[e]) * bfhi(o4[e]));
        *(u32x4*)orow = y; }
}

__device__ __forceinline__ void sgu_conv_item(Frame& F, int l, int lc) {
    PHASE_IDS();
    bf16* zx = (bf16*)(F.ws + WS_ZX);
    LAS bf16* W = (LAS bf16*)F.lds; LAS bf16* VN = W + 128 * LDT;
    __syncthreads();
    const int t = tid >> 2, part = tid & 3;
    u32x4 gv[16]; float mu, rs;
    { const u32x4* p = (const u32x4*)(zx + (size_t)(lc * 128 + t) * ZW + ZC_SV + part * 128);
        float s1 = 0.f, s2 = 0.f;
#pragma unroll
        for (int q = 0; q < 16; ++q) gv[q] = p[q];
#pragma unroll
        for (int q = 0; q < 16; ++q) {
#pragma unroll
            for (int e = 0; e < 4; ++e) { const float a = bflo(gv[q][e]), b = bfhi(gv[q][e]); s1 += a + b; s2 += a * a + b * b; } }
        s1 += __shfl_xor(s1, 1); s1 += __shfl_xor(s1, 2); s2 += __shfl_xor(s2, 1); s2 += __shfl_xor(s2, 2);
        mu = s1 * (1.0f / 512.0f); rs = __builtin_amdgcn_rsqf(fmaxf(s2 * (1.0f / 512.0f) - mu * mu, 0.f) + RMS_EPS); }
#pragma unroll 1
    for (int sg = 0; sg < 4; ++sg) {
        if (sg) __syncthreads();
        if (part == sg) {
#pragma unroll
            for (int q = 0; q < 16; ++q) { u32x4 o;
#pragma unroll
                for (int e = 0; e < 4; ++e) o[e] = pk2((bflo(gv[q][e]) - mu) * rs, (bfhi(gv[q][e]) - mu) * rs);
                *(LAS u32x4*)(VN + t * LDT + q * 8) = o; } }
        { const float* ws = F.in[I_WSGU] + (size_t)(l * 4 + sg) * 128 * 128;
            f32x4 w4[8];
#pragma unroll
            for (int q = 0; q < 8; ++q) { const int idx = q * 512 + tid; w4[q] = *(const f32x4*)(ws + (idx >> 5) * 128 + (idx & 31) * 4); }
#pragma unroll
            for (int q = 0; q < 8; ++q) { const int idx = q * 512 + tid, tt = idx >> 5, s0 = (idx & 31) * 4;
                *(LAS u32x2*)(W + tt * LDT + s0) = (u32x2){pk2(w4[q][0], w4[q][1]), pk2(w4[q][2], w4[q][3])}; } }
        const int d0 = wave * 16 + (lane >> 4) * 4;
        u32x2 supre[8];
#pragma unroll
        for (int n = 0; n < 8; ++n) supre[n] = *(const u32x2*)(zx + (size_t)(lc * 128 + n * 16 + (lane & 15)) * ZW + ZC_SU + sg * 128 + d0);
        __syncthreads();
        f32x4 acc[8];
#pragma unroll
        for (int n = 0; n < 8; ++n) acc[n] = (f32x4){0.f, 0.f, 0.f, 0.f};
#pragma unroll
        for (int ks = 0; ks < 4; ++ks) { const bf16x8 a = frag_tr(VN, LDT, ks * 32, wave * 16, lane);
            bf16x8 bfr[8];
#pragma unroll
            for (int n = 0; n < 8; ++n) bfr[n] = *(const LAS bf16x8*)(W + (n * 16 + (lane & 15)) * LDT + ks * 32 + (lane >> 4) * 8);
#pragma unroll
            for (int n = 0; n < 8; ++n) acc[n] = __builtin_amdgcn_mfma_f32_16x16x32_bf16(a, bfr[n], acc[n], 0, 0, 0); }
        const f32x4 g4 = *(const f32x4*)(F.in[I_GSGU] + l * 512 + sg * 128 + d0);
        const float* bs = F.in[I_BSGU] + (l * 4 + sg) * 128;
        float btv[8];
#pragma unroll
        for (int n = 0; n < 8; ++n) btv[n] = bs[n * 16 + (lane & 15)];
#pragma unroll
        for (int n = 0; n < 8; ++n) { const int tt = n * 16 + (lane & 15); const float bt = btv[n];
            u32x2* p = (u32x2*)(zx + (size_t)(lc * 128 + tt) * ZW + ZC_SU + sg * 128 + d0); const u32x2 su = supre[n];
            u32x2 o; o.x = pk2(bflo(su.x) * (g4[0] * acc[n][0] + bt), bfhi(su.x) * (g4[1] * acc[n][1] + bt));
            o.y = pk2(bflo(su.y) * (g4[2] * acc[n][2] + bt), bfhi(su.y) * (g4[3] * acc[n][3] + bt));
            *p = o; }
    }
    {
        const int rg = tid >> 4, c8 = (tid & 15) * 8, s0 = 4 * rg; bool hl, hr, d0_, d1_; nbr_flags(lc, s0, hl, d0_); nbr_flags(lc, s0 + 3, d1_, hr);
#pragma unroll 1
        for (int sg = 0; sg < 4; ++sg) { const int ch = sg * 128 + c8;
            float w[24];
#pragma unroll
            for (int j = 0; j < 3; ++j) { const f32x4 w0 = *(const f32x4*)(F.in[I_WSCONV] + (size_t)(l * 3 + j) * 512 + ch), w1 = *(const f32x4*)(F.in[I_WSCONV] + (size_t)(l * 3 + j) * 512 + ch + 4);
#pragma unroll
                for (int e = 0; e < 4; ++e) { w[j * 8 + e] = w0[e]; w[j * 8 + 4 + e] = w1[e]; } }
            const bf16* pc = zx + (size_t)(lc * 128 + s0) * ZW + ZC_CC + ch; const bf16* px = zx + (size_t)(lc * 128 + s0) * ZW + ZC_CX + ch; bf16* pb = zx + (size_t)(lc * 128 + s0) * ZW + ZC_CB + ch;
            u32x4 c[6], x[6], cb[4]; const u32x4 z4 = zero4();
            c[0] = hl ? *(const u32x4*)(pc - ZW) : z4; x[0] = hl ? *(const u32x4*)(px - ZW) : z4;
#pragma unroll
            for (int i = 0; i < 4; ++i) { c[1 + i] = *(const u32x4*)(pc + (size_t)i * ZW); x[1 + i] = *(const u32x4*)(px + (size_t)i * ZW); cb[i] = *(const u32x4*)(pb + (size_t)i * ZW); }
            c[5] = hr ? *(const u32x4*)(pc + (size_t)4 * ZW) : z4; x[5] = hr ? *(const u32x4*)(px + (size_t)4 * ZW) : z4;
            float pl[6][8];
#pragma unroll
            for (int r = 0; r < 6; ++r)
#pragma unroll
                for (int e = 0; e < 4; ++e) { pl[r][2 * e] = bflo(c[r][e]) * bflo(x[r][e]); pl[r][2 * e + 1] = bfhi(c[r][e]) * bfhi(x[r][e]); }
#pragma unroll
            for (int i = 0; i < 4; ++i) { u32x4 o;
#pragma unroll
                for (int e = 0; e < 4; ++e) { const float y0 = bflo(cb[i][e]) * (w[2 * e] * pl[i][2 * e] + w[8 + 2 * e] * pl[i + 1][2 * e] + w[16 + 2 * e] * pl[i + 2][2 * e]);
                    const float y1 = bfhi(cb[i][e]) * (w[2 * e + 1] * pl[i][2 * e + 1] + w[8 + 2 * e + 1] * pl[i + 1][2 * e + 1] + w[16 + 2 * e + 1] * pl[i + 2][2 * e + 1]); o[e] = pk2(y0, y1); }
                *(u32x4*)(pb + (size_t)i * ZW) = o; } }
    }
}

__device__ __forceinline__ void s5_out_item(Frame& F, int l, int lc, int q) {
    PHASE_IDS();
    bf16* zx = (bf16*)(F.ws + WS_ZX);
    LAS bf16* U16 = (LAS bf16*)(F.lds + wave * 10752); LAS bf16* BX = U16 + 32 * 32;
    LAS bf16* Y = (LAS bf16*)(F.lds + 86016);
    constexpr int LDY = 392;
    const int p = lane, row0 = lc * 128 + q * 32;
    const f32x2* E = (const f32x2*)(F.ws + WS_S5E); const f32x2* X = (const f32x2*)(F.ws + WS_MISC + MS_S5X);
    __syncthreads();
    { const int t = lane >> 1, h8 = (lane & 1) * 8; *(LAS u32x4*)(U16 + t * 32 + 16 + h8) = zero4(); }
    f32x4 n_ab4; f32x2 n_ab2, n_x0, n_e0; u32x4 n_bb[8], n_u, n_cf[4]; float n_dj;
#define S5_LOAD_COMBO(c_) do { const int g5_ = wave * 3 + ((c_) >> 1), dir_ = (c_) & 1, qs_ = dir_ ? 3 - q : q; \
        const f32x4 ab4_ = *(const f32x4*)((const float*)(F.ws + WS_S5T + S5T_AB) + (size_t)((dir_ * 24 + g5_) * 64 + p) * 6 - (p & 1) * 2); \
        const f32x2 ab2_ = *(const f32x2*)((const float*)(F.ws + WS_S5T + S5T_AB) + (size_t)((dir_ * 24 + g5_) * 64 + p) * 6 + 4 - (p & 1) * 2); \
        n_ab4 = ab4_; n_ab2 = ab2_; \
        n_x0 = X[((size_t)(lc * 2 + dir_) * 24 + g5_) * 64 + p]; \
        n_e0 = E[((size_t)((lc * 2 + dir_) * 4 + (qs_ > 0 ? qs_ - 1 : 0)) * 24 + g5_) * 64 + p]; \
        const u32x4* bbf_ = (const u32x4*)(F.ws + WS_S5T + S5T_BB) + (size_t)(dir_ * 24 + g5_) * 8 * 64; \
        _Pragma("unroll") for (int pt_ = 0; pt_ < 8; ++pt_) n_bb[pt_] = bbf_[pt_ * 64 + lane]; } while (0)
#define S5_LOAD_GROUP(gi_) do { const int g5_ = wave * 3 + (gi_); const int t_ = lane >> 1, h8_ = (lane & 1) * 8; \
        n_u = *(const u32x4*)(zx + (size_t)(row0 + t_) * ZW + ZC_U + g5_ * 16 + h8_); \
        _Pragma("unroll") for (int ks_ = 0; ks_ < 4; ++ks_) n_cf[ks_] = ((const u32x4*)(F.ws + WS_S5T + S5T_CC))[(g5_ * 4 + ks_) * 64 + lane]; \
        n_dj = F.in[I_S5D][l * 384 + g5_ * 16 + (lane & 15)]; } while (0)
    S5_LOAD_GROUP(0); S5_LOAD_COMBO(0);
    bf16x8 cf[4]; float dj = 0.f; f32x4 ay[2];
#pragma unroll 1
    for (int c = 0; c < 6; ++c) {
        const int g5 = wave * 3 + (c >> 1), dir = c & 1;
        if (dir == 0) {
            { const int t = lane >> 1, h8 = (lane & 1) * 8; *(LAS u32x4*)(U16 + t * 32 + h8) = n_u; }
#pragma unroll
            for (int ks = 0; ks < 4; ++ks) cf[ks] = __builtin_bit_cast(bf16x8, n_cf[ks]);
            dj = n_dj; ay[0] = (f32x4){0.f, 0.f, 0.f, 0.f}; ay[1] = (f32x4){0.f, 0.f, 0.f, 0.f};
        }
        const bool odd = p & 1;
        const float ab_re = odd ? n_ab4[2] : n_ab4[0], ab_im = odd ? n_ab4[3] : n_ab4[1], pr = odd ? n_ab2[0] : n_ab4[2], pi = odd ? n_ab2[1] : n_ab4[3];
        const int qs = dir ? 3 - q : q;
        float xr = n_x0.x, xi = n_x0.y;
        for (int s_ = 0; s_ < qs; ++s_) cmul(xr, xi, pr, pi);
        if (qs > 0) { xr += n_e0.x; xi += n_e0.y; }
        u32x4 bb[8];
#pragma unroll
        for (int pt = 0; pt < 8; ++pt) bb[pt] = n_bb[pt];
        if (c < 5) { S5_LOAD_COMBO(c + 1); if (dir == 1) S5_LOAD_GROUP((c + 1) >> 1); }
        LDS_WAIT(); asm volatile("" ::: "memory");
        {
            const bf16x8 b0 = *(const LAS bf16x8*)(U16 + (lane & 15) * 32 + (lane >> 4) * 8), b1 = *(const LAS bf16x8*)(U16 + (16 + (lane & 15)) * 32 + (lane >> 4) * 8);
#pragma unroll
            for (int pt = 0; pt < 8; ++pt) { const bf16x8 a = __builtin_bit_cast(bf16x8, bb[pt]); const f32x4 z = (f32x4){0.f, 0.f, 0.f, 0.f};
                const f32x4 o0 = __builtin_amdgcn_mfma_f32_16x16x32_bf16(a, b0, z, 0, 0, 0), o1 = __builtin_amdgcn_mfma_f32_16x16x32_bf16(a, b1, z, 0, 0, 0);
                *(LAS u32x2*)(BX + (lane & 15) * LDT + pt * 16 + (lane >> 4) * 4) = (u32x2){pk2(o0[0], o0[1]), pk2(o0[2], o0[3])};
                *(LAS u32x2*)(BX + (16 + (lane & 15)) * LDT + pt * 16 + (lane >> 4) * 4) = (u32x2){pk2(o1[0], o1[1]), pk2(o1[2], o1[3])}; } }
        LDS_WAIT(); asm volatile("" ::: "memory");
        unsigned wv[32];
#pragma unroll
        for (int k = 0; k < 32; ++k) { const int tl = dir ? 31 - k : k; wv[k] = *(const LAS unsigned*)(BX + tl * LDT + 2 * p); }
#pragma unroll
        for (int k = 0; k < 32; ++k) { const float bur = bflo(wv[k]), bui = bfhi(wv[k]);
            const float nr = ab_re * xr - ab_im * xi + bur, ni = ab_re * xi + ab_im * xr + bui; xr = nr; xi = ni; wv[k] = pk2(xr, xi); }
#pragma unroll
        for (int k = 0; k < 32; ++k) { const int tl = dir ? 31 - k : k; *(LAS unsigned*)(BX + tl * LDT + 2 * p) = wv[k]; }
        LDS_WAIT(); asm volatile("" ::: "memory");
        { bf16x8 afr[8];
#pragma unroll
            for (int q8 = 0; q8 < 8; ++q8) afr[q8] = *(const LAS bf16x8*)(BX + ((q8 >> 2) * 16 + (lane & 15)) * LDT + (q8 & 3) * 32 + (lane >> 4) * 8);
#pragma unroll
            for (int q8 = 0; q8 < 8; ++q8) ay[q8 >> 2] = __builtin_amdgcn_mfma_f32_16x16x32_bf16(afr[q8], cf[q8 & 3], ay[q8 >> 2], 0, 0, 0); }
        if (dir == 1) {
            const int j = lane & 15;
#pragma unroll
            for (int tt = 0; tt < 2; ++tt)
#pragma unroll
                for (int i = 0; i < 4; ++i) { const int t = tt * 16 + (lane >> 4) * 4 + i; const float y = geluf_(ay[tt][i] + dj * bf2f(U16[t * 32 + j])); Y[t * LDY + g5 * 16 + j] = (bf16)f2bf(y); }
            LDS_WAIT(); asm volatile("" ::: "memory");
        }
    }
#undef S5_LOAD_COMBO
#undef S5_LOAD_GROUP
    __syncthreads();
    f32x4 az[2][3];
#pragma unroll
    for (int tt = 0; tt < 2; ++tt)
#pragma unroll
        for (int n = 0; n < 3; ++n) az[tt][n] = (f32x4){0.f, 0.f, 0.f, 0.f};
    const bf16* wg = (const bf16*)(F.ws + WS_WGLU);
#pragma unroll 1
    for (int k4 = 0; k4 < 3; ++k4) {
        bf16x8 a[4][2], b[4][3];
#pragma unroll
        for (int kk = 0; kk < 4; ++kk)
#pragma unroll
            for (int n = 0; n < 3; ++n) b[kk][n] = *(const bf16x8*)(wg + (size_t)(wave * 48 + n * 16 + (lane & 15)) * 384 + (k4 * 4 + kk) * 32 + (lane >> 4) * 8);
#pragma unroll
        for (int kk = 0; kk < 4; ++kk)
#pragma unroll
            for (int tt = 0; tt < 2; ++tt) a[kk][tt] = *(const LAS bf16x8*)(Y + (tt * 16 + (lane & 15)) * LDY + (k4 * 4 + kk) * 32 + (lane >> 4) * 8);
        __builtin_amdgcn_sched_barrier(0);
#pragma unroll
        for (int kk = 0; kk < 4; ++kk)
#pragma unroll
            for (int tt = 0; tt < 2; ++tt)
#pragma unroll
                for (int n = 0; n < 3; ++n) az[tt][n] = __builtin_amdgcn_mfma_f32_16x16x32_bf16(a[kk][tt], b[kk][n], az[tt][n], 0, 0, 0);
    }
    const float* bgl = F.in[I_BGLU] + l * 384;
    float bgv[3];
#pragma unroll
    for (int n = 0; n < 3; ++n) bgv[n] = bgl[wave * 48 + n * 16 + (lane & 15)];
#pragma unroll
    for (int tt = 0; tt < 2; ++tt)
#pragma unroll
        for (int n = 0; n < 3; ++n) { const int col = wave * 48 + n * 16 + (lane & 15); const float bb = bgv[n];
#pragma unroll
            for (int i = 0; i < 4; ++i) { const int t = tt * 16 + (lane >> 4) * 4 + i; const float y = bf2f(Y[t * LDY + col]);
                zx[(size_t)(row0 + t) * ZW + ZC_U + col] = (bf16)f2bf(y * sigmoidf_(az[tt][n][i] + bb)); } }
}

__device__ __forceinline__ void zero_cols(Frame& F, int col0, int n8, int nrows) {
    PHASE_IDS();
    bf16* zx = (bf16*)(F.ws + WS_ZX);
    for (int idx = F.vcu * NTHR + tid; idx < nrows * n8; idx += F.G * NTHR) { const int r = idx / n8, c = idx % n8; *(u32x4*)(zx + (size_t)r * ZW + col0 + c * 8) = (u32x4){0u, 0u, 0u, 0u}; }
}
constexpr int CW_QUEUE = 8192;
__device__ __forceinline__ int next_item(Frame& F, int qid, int cur, int tid) {
    volatile LAS unsigned* slot = (volatile LAS unsigned*)(F.lds + MISC_OFF) + 16;
    __syncthreads();
    if (tid == 0) *slot = (unsigned)F.G + __hip_atomic_fetch_add((unsigned*)(F.ws + WS_CTL) + CW_QUEUE + 64 * qid, 1u, __ATOMIC_RELAXED, __HIP_MEMORY_SCOPE_AGENT);
    __syncthreads();
    (void)cur; return (int)*slot;
}
__device__ __forceinline__ void pass1_phase(Frame& F, int l, int qid) {
    constexpr int N_ML = NLC * 4, N_S5 = NLC * 6;
    int tid0 = threadIdx.x; asm volatile("" : "+v"(tid0));
    for (int it = F.vcu; it < N_ML + N_S5; it = next_item(F, qid, it, tid0)) {
        if (it < N_S5) { if (MASK & 8) s5_local_item(F, l, it / 6, it % 6); }
        else if (MASK & 16) { const int r = it - N_S5; mlstm_local_item(F, l, r >> 2, r & 3); }
    }
}
__device__ __forceinline__ void pass2_phase(Frame& F, int l, int nlc, int qid) {
    const int n4 = nlc * 4;
    int tid0 = threadIdx.x; asm volatile("" : "+v"(tid0));
    for (int it = F.vcu; it < 2 * n4 + nlc; it = next_item(F, qid, it, tid0)) {
        if (it < nlc) { if (MASK & 4) sgu_conv_item(F, l, it); }
        else if (it < nlc + n4) { if (MASK & 8) { const int r = it - nlc; s5_out_item(F, l, r >> 2, r & 3); } }
        else if (MASK & 16) { const int r = it - nlc - n4; mlstm_out_item(F, l, r >> 2, r & 3); }
    }
    if (!(MASK & 16)) zero_cols(F, ZC_O, 64, nlc * 128);
    if (!(MASK & 8)) zero_cols(F, ZC_U, 48, nlc * 128);
    if (!(MASK & 4)) { zero_cols(F, ZC_SU, 64, nlc * 128); zero_cols(F, ZC_CB, 64, nlc * 128); }
}

struct EpiStoreBf16 {
    static constexpr bool PERM = true;
    bf16* O;
    __device__ __forceinline__ void operator()(const f32x4 (&acc)[2][2][4][2], const pg8::Unit& u, int wr, int wc, int fr, int fq) const {
        const int row0 = u.pm * 256 + wr * 64 + fr, col0 = u.pn * 256 + wc * 32 + 8 * fq;
        const int act = (u.pn >= 20 || u.pn == 8 || u.pn == 9) ? 1 : ((u.pn >= 10 && u.pn < 14) ? 2 : 0);
#pragma unroll
        for (int ai = 0; ai < 2; ++ai)
#pragma unroll
            for (int m = 0; m < 4; ++m) { bf16* rowp = O + (size_t)(row0 + ai * 128 + m * 16) * ZW + col0;
#pragma unroll
                for (int bj = 0; bj < 2; ++bj) { f32x4 v0 = acc[ai][bj][m][0], v1 = acc[ai][bj][m][1];
                    if (act == 1) {
#pragma unroll
                        for (int e = 0; e < 4; ++e) { v0[e] = sigmoidf_(v0[e]); v1[e] = sigmoidf_(v1[e]); } }
                    else if (act == 2) {
#pragma unroll
                        for (int e = 0; e < 4; ++e) { v0[e] = geluf_(v0[e]); v1[e] = geluf_(v1[e]); } }
                    u32x4 w; w.x = pk2(v0[0], v0[1]); w.y = pk2(v0[2], v0[3]); w.z = pk2(v1[0], v1[1]); w.w = pk2(v1[2], v1[3]);
                    *(u32x4*)(rowp + bj * 128) = w; } }
    }
};
struct EpiGateCat {
    static constexpr bool PERM = true;
    const bf16* zx; bf16* mg;
    __device__ __forceinline__ void rescale(f32x4 (&acc)[2][2][4][2], const pg8::Unit& u, int t, int wr, int wc, int fr, int fq) const {
        const int b = t == 8 ? 0 : (t == 16 ? 1 : 2);
        const int rl0 = u.pm * 256 + wr * 64 + fr, col0 = u.pn * 256 + wc * 32 + 8 * fq;
#pragma unroll
        for (int ai = 0; ai < 2; ++ai) {
            u32x4 ga[4][2], gb[4][2];
#pragma unroll
            for (int m = 0; m < 4; ++m) { const bf16* gp = zx + (size_t)(rl0 + ai * 128 + m * 16) * ZW + ZC_BG + b * 1024 + col0;
#pragma unroll
                for (int bj = 0; bj < 2; ++bj) { ga[m][bj] = *(const u32x4*)(gp + bj * 128); gb[m][bj] = *(const u32x4*)(gp + 1024 + bj * 128); } }
#pragma unroll
            for (int m = 0; m < 4; ++m)
#pragma unroll
                for (int bj = 0; bj < 2; ++bj)
#pragma unroll
                    for (int e = 0; e < 4; ++e) { const int n = e >> 1, c = (e & 1) * 2;
                        acc[ai][bj][m][n][c] *= fmaxf(bflo(ga[m][bj][e]), 1e-20f) * rcpf_(fmaxf(bflo(gb[m][bj][e]), 1e-20f));
                        acc[ai][bj][m][n][c + 1] *= fmaxf(bfhi(ga[m][bj][e]), 1e-20f) * rcpf_(fmaxf(bfhi(gb[m][bj][e]), 1e-20f)); }
            asm volatile("" ::: "memory"); }
    }
    __device__ __forceinline__ void operator()(const f32x4 (&acc)[2][2][4][2], const pg8::Unit& u, int wr, int wc, int fr, int fq) const {
        const int rl0 = u.pm * 256 + wr * 64 + fr, rg0 = u.pmg * 256 + wr * 64 + fr, col0 = u.pn * 256 + wc * 32 + 8 * fq;
#pragma unroll
        for (int ai = 0; ai < 2; ++ai) {
            u32x4 gw[4][2];
#pragma unroll
            for (int m = 0; m < 4; ++m) { const bf16* gp = zx + (size_t)(rl0 + ai * 128 + m * 16) * ZW + ZC_BG + 3 * 1024 + col0;
#pragma unroll
                for (int bj = 0; bj < 2; ++bj) gw[m][bj] = *(const u32x4*)(gp + bj * 128); }
#pragma unroll
            for (int m = 0; m < 4; ++m) { bf16* mp = mg + (size_t)(rg0 + ai * 128 + m * 16) * D + col0;
#pragma unroll
                for (int bj = 0; bj < 2; ++bj) { const u32x4 g_ = gw[m][bj]; const f32x4 v0 = acc[ai][bj][m][0], v1 = acc[ai][bj][m][1]; u32x4 w;
                    w.x = pk2(fmaxf(bflo(g_.x), 1e-20f) * v0[0], fmaxf(bfhi(g_.x), 1e-20f) * v0[1]); w.y = pk2(fmaxf(bflo(g_.y), 1e-20f) * v0[2], fmaxf(bfhi(g_.y), 1e-20f) * v0[3]);
                    w.z = pk2(fmaxf(bflo(g_.z), 1e-20f) * v1[0], fmaxf(bfhi(g_.z), 1e-20f) * v1[1]); w.w = pk2(fmaxf(bflo(g_.w), 1e-20f) * v1[2], fmaxf(bfhi(g_.w), 1e-20f) * v1[3]);
                    *(u32x4*)(mp + bj * 128) = w; } }
            asm volatile("" ::: "memory"); }
    }
};
struct OrderIn {
    const char* hn; const char* win; int g, G, c;
    __device__ __forceinline__ bool next(int i, pg8::Unit& u) const {
        const int L = i * G + c; if (L >= 34 * 36) return false;
        int pm, pn; pg8::tile_of(L, 34, 36, pm, pn);
        u.pm = pm; u.pn = pn; u.pmg = gtile_of(g, pm); u.br = 0; u.nt = 16;
        u.A = hn + (size_t)u.pmg * 256 * D * 2; u.B = win + (size_t)pn * 256 * D * 2; return true;
    }
};
struct OrderUp {
    const char* zx; const char* wup; int g, nOT, G, bx;
    __device__ __forceinline__ bool next(int i, pg8::Unit& u) const {
        if (i > 0) return false;
        const int per = (nOT + 7) >> 3, slot = bx >> 3, ot = (bx & 7) * per + slot; if (slot >= per || ot >= nOT) return false;
        const int pm = ot >> 2, pn = ot & 3;
        u.pm = pm; u.pn = pn; u.pmg = gtile_of(g, pm); u.br = 0; u.nt = 30;
        u.A = zx + (size_t)pm * 256 * ZW * 2; u.B = wup + (size_t)pn * 256 * 1920 * 2; return true;
    }
};

__global__ void __launch_bounds__(NTHR, 2) fwd_kernel(Args args) {
    extern __shared__ __attribute__((aligned(16))) unsigned char lds[];
    Frame F;
    F.lds = (LAS unsigned char*)lds;
    volatile LAS unsigned* MISC = (volatile LAS unsigned*)(F.lds + MISC_OFF);
    const int tid = threadIdx.x;
    F.G = gridDim.x; { const int bx = blockIdx.x; F.vcu = (F.G % 8 == 0) ? (bx % 8) * (F.G / 8) + bx / 8 : bx; }
    F.in = args.in; F.out = args.out; F.ws = args.ws;
    for (int u = tid; u < (LDS_BYTES - LDSCTL_OFF) / 4; u += NTHR) ((LAS unsigned*)(F.lds + LDSCTL_OFF))[u] = 0u;
    __syncthreads();
    unsigned* ctl = (unsigned*)(args.ws + WS_CTL);
    XcdBarrier bar = xcd_barrier_post(ctl + CW_BAR, MISC + 8);
#define GRID_BAR() do { XcdBarrier b_ = bar; asm volatile("" : "+s"(b_.x), "+s"(b_.bar)); xcd_barrier(b_); } while (0)

    p0_mods(F);
    p0_weights(F, 0);
    s5_tables(F, 0);
    GRID_BAR();

    float* xc = (float*)(F.ws + WS_XC);
#pragma unroll 1
    for (int l = 0; l < DEPTH; ++l) {
        asm volatile("" : "+s"(F.ws), "+s"(F.out));
        const bool last = (l == DEPTH - 1);
        const float* xin_l = (l == 0) ? F.in[I_X] : F.out;
        const float* xin_c = (l == 0) ? F.in[I_CTX] : xc;
        const int nMg = ((MASK & 2) && !last) ? 68 : 64;
        if (l > 0) { p0_weights(F, l); s5_tables(F, l); }
        if (MASK & 2) {
            norm_phase(F, xin_l, xin_c, F.in[I_GNMIX] + l * D, l, 0, MTOT);
            GRID_BAR();
#pragma unroll 1
            for (int g = 0; g < NGRP; ++g) {
                asm volatile("" : "+s"(F.ws));
                { OrderIn S{(const char*)(F.ws + WS_HN), (const char*)(F.ws + WS_WIN), g, F.G, (int)blockIdx.x};
                  EpiStoreBf16 E{(bf16*)(F.ws + WS_ZX)};
                  pg8::gemm_phase<EpiStoreBf16, OrderIn, D, D>(F.lds, S, E); }
                GRID_BAR();
                if (MASK & 24) { pass1_phase(F, l, (l * 2 + g) * 2); GRID_BAR(); scan_phase(F, l); GRID_BAR(); }
                pass2_phase(F, l, last ? 64 : 68, (l * 2 + g) * 2 + 1);
                GRID_BAR();
                { OrderUp S{(const char*)(F.ws + WS_ZX), (const char*)(F.ws + WS_WUP), g, (last ? 32 : 34) * 4, F.G, (int)blockIdx.x};
                  EpiGateCat E{(const bf16*)(F.ws + WS_ZX), (bf16*)(F.ws + WS_HN)};
                  pg8::gemm_phase<EpiGateCat, OrderUp, ZW, 1920, true, true, true>(F.lds, S, E); }
                GRID_BAR();
            }
            { OrderGlobal S{(const char*)(F.ws + WS_HN), (const char*)(F.ws + WS_WOUT), D, D, nMg, D / 256, D / 64, F.G, (int)blockIdx.x};
              EpiResid E{xin_l, xin_c, F.out, xc, modp(F, l, 0, 2)};
              pg8::gemm_phase<EpiResid, OrderGlobal, D, D>(F.lds, S, E); }
            GRID_BAR();
        }
        const float* x1_l = (MASK & 2) ? F.out : xin_l; const float* x1_c = (MASK & 2) ? xc : xin_c;
        norm_phase(F, x1_l, x1_c, F.in[I_GNFFN] + l * D, l, 3, nMg * 256);
        GRID_BAR();
        { OrderGlobal S{(const char*)(F.ws + WS_HN), (const char*)(F.ws + WS_WFF1), D, D, nMg, FF2 / 256, D / 64, F.G, (int)blockIdx.x};
          EpiSwiglu E{(bf16*)(F.ws + WS_ZX)};
          pg8::gemm_phase<EpiSwiglu, OrderGlobal, D, D>(F.lds, S, E); }
        GRID_BAR();
        { OrderGlobal S{(const char*)(F.ws + WS_ZX), (const char*)(F.ws + WS_WFF2), FFH, FFH, nMg, D / 256, FFH / 64, F.G, (int)blockIdx.x};
          EpiResid E{x1_l, x1_c, F.out, xc, modp(F, l, 0, 5)};
          pg8::gemm_phase<EpiResid, OrderGlobal, FFH, FFH>(F.lds, S, E); }
        GRID_BAR();
    }
    final_norm_phase(F);
}

extern "C" void kernel_launch(void* const* d_in, const int* in_sizes, int n_in, void* d_out, int out_size, void* d_ws, size_t ws_size, hipStream_t stream) {
    static int grid = 0;
    if (grid == 0) {
        if (n_in != N_IN || ws_size < WS_END || out_size != MLAT * D) { fprintf(stderr, "kernel_launch: unexpected n_in %d / ws %zu / out %d\n", n_in, ws_size, out_size); grid = -1; return; }
        int dev = 0, cus = 0, per_cu = 0;
        if (hipGetDevice(&dev) != hipSuccess || hipDeviceGetAttribute(&cus, hipDeviceAttributeMultiprocessorCount, dev) != hipSuccess) { grid = -1; return; }
        if (hipFuncSetAttribute((const void*)fwd_kernel, hipFuncAttributeMaxDynamicSharedMemorySize, LDS_BYTES) != hipSuccess) { grid = -1; return; }
        if (hipOccupancyMaxActiveBlocksPerMultiprocessor(&per_cu, (const void*)fwd_kernel, NTHR, LDS_BYTES) != hipSuccess || per_cu < 1) { fprintf(stderr, "occupancy query: %d\n", per_cu); grid = -1; return; }
        grid = cus;
    }
    if (grid < 0) return;
    (void)hipMemsetAsync((char*)d_ws + WS_CTL, 0, CTL_ZERO_BYTES, stream);
    Args a{};
    for (int i = 0; i < N_IN; ++i) a.in[i] = (const float*)d_in[i];
    a.out = (float*)d_out; a.ws = (unsigned char*)d_ws;
    void* kargs[] = {&a};
    hipError_t e = hipLaunchCooperativeKernel((const void*)fwd_kernel, dim3(grid), dim3(NTHR), kargs, LDS_BYTES, stream);
    if (e != hipSuccess) fprintf(stderr, "cooperative launch failed: %s (grid %d)\n", hipGetErrorString(e), grid);
}
```

```cpp
#include <hip/hip_runtime.h>
#include <hip/hip_cooperative_groups.h>
#include <cstdio>
#include <cstdint>
namespace cg = cooperative_groups;

#ifndef MASK
#define MASK 31
#endif

#define GAS __attribute__((address_space(1)))
#define LAS __attribute__((address_space(3)))
typedef unsigned short bf16;
typedef float f32x4 __attribute__((ext_vector_type(4)));
typedef float f32x2 __attribute__((ext_vector_type(2)));
typedef short bf16x8 __attribute__((ext_vector_type(8)));
typedef unsigned u32x4 __attribute__((ext_vector_type(4)));
typedef unsigned u32x2 __attribute__((ext_vector_type(2)));

constexpr int NWAVES = 8, NTHR = 512;
constexpr int D = 1024, BATCH = 4, SEQ = 4096, CTXL = 256, DEPTH = 2;
constexpr int MLAT = BATCH * SEQ, MCTX = BATCH * CTXL, MTOT = MLAT + MCTX;
constexpr int IN_DIM = 9104, ZW = 9216, FFH = 2816, FF2 = 2 * FFH;
constexpr int NGRP = 2, GROWS = MTOT / NGRP;
constexpr float RMS_EPS = 1e-6f;
enum { I_X = 0, I_C, I_CTX, I_CCTX, I_WMOD, I_BMOD, I_GNMIX, I_GNFFN, I_WIN, I_BGATES, I_WCONVQK, I_GMH, I_GSGU, I_WSGU, I_BSGU,
       I_S5ARE, I_S5AIM, I_S5LOGDT, I_S5BRE, I_S5BIM, I_S5CRE, I_S5CIM, I_S5D, I_WGLU, I_BGLU, I_WSCONV, I_WUPM, I_WUPSGU, I_WUPS5, I_WUPSC,
       I_WOUT, I_WFFG, I_WFFU, I_WFFD, I_GFINAL, N_IN };

constexpr size_t MiB = 1u << 20;
constexpr size_t WS_CTL = 0, CTL_ZERO_BYTES = 1 * MiB;
constexpr size_t WS_MOD = 1 * MiB;
constexpr size_t WS_WIN = 2 * MiB;
constexpr size_t WS_WUP = 20 * MiB;
constexpr size_t WS_WOUT = 24 * MiB;
constexpr size_t WS_WFF1 = 26 * MiB;
constexpr size_t WS_WFF2 = 37 * MiB;
constexpr size_t WS_WGLU = 43 * MiB;
constexpr size_t WS_S5T = 43 * MiB + 320 * 1024;
constexpr size_t WS_XC = 44 * MiB;
constexpr size_t WS_HN = 48 * MiB;
constexpr size_t WS_MST = 82 * MiB;
constexpr size_t WS_S5E = 116 * MiB;
constexpr size_t WS_MISC = 123 * MiB;
constexpr size_t WS_ZX = 126 * MiB;
constexpr size_t WS_END = 279 * MiB;
constexpr int CW_BAR = 4096;

constexpr int LDS_BYTES = 147456;
constexpr int LDSCTL_OFF = LDS_BYTES - 512, MISC_OFF = LDSCTL_OFF + 320;

namespace pg8 {
#define PG8_LAS __attribute__((address_space(3)))
typedef unsigned short bf16_t;
constexpr int BM = 256, BK = 64, HALF = 128, HTB = HALF * BK * 2, STAGE_BYTES = 8 * HTB, NXCD = 8, WGM = 8;
__host__ __device__ __forceinline__ int lds_byte(int r, int c) { const int st = (r >> 4) * 2 + (c >> 5), rr = r & 15, cc = c & 31, ob = rr * 64 + cc * 2; return st * 1024 + (ob ^ (((ob >> 9) & 1) << 5)); }
__host__ __device__ __forceinline__ void stage_rc(int b, int& R, int& C) { const int st = b / 1024, sb = b % 1024, swz = sb ^ (((sb >> 9) & 1) << 5); R = (st >> 1) * 16 + swz / 64; C = (st & 1) * 32 + (swz % 64) / 2; }
__host__ __device__ __forceinline__ int perm32(int rho) { const int n = rho >> 4, i = rho & 15; return 8 * (i >> 2) + 4 * n + (i & 3); }

struct Unit { int pm, pn; const char* A; const char* B; int nt; int pmg; int br; };
struct Ld { int lda, ldb; };
__device__ __forceinline__ void tile_of(int L, int nM, int nN, int& pm, int& pn) {
    const int nwg = nM * nN; int wgid = L; { const int q = nwg / NXCD, r = nwg % NXCD, xcd = wgid % NXCD, off = wgid / NXCD; wgid = (xcd < r ? xcd * (q + 1) : r * (q + 1) + (xcd - r) * q) + off; }
    const int nig = WGM * nN, gid = wgid / nig, fm = gid * WGM, gsz = (nM - fm) < WGM ? (nM - fm) : WGM;
    pm = fm + ((wgid % nig) % gsz); pn = (wgid % nig) / gsz;
}
__device__ __forceinline__ unsigned cvt_pk_bf16(float lo, float hi) { unsigned r; asm volatile("v_cvt_pk_bf16_f32 %0, %1, %2" : "=v"(r) : "v"(lo), "v"(hi)); return r; }

__device__ __forceinline__ size_t kcat_off(int t) { return t < 8 ? (size_t)2048 * 2 + t * 128 : t < 16 ? (size_t)2560 * 2 + (t - 8) * 128 : t < 22 ? (size_t)1536 * 2 + (t - 16) * 128 : (size_t)3584 * 2 + (t - 22) * 128; }
template <class Epi, class Sched, int LDA, int LDB, bool ALIGN_EPI = true, bool SP2 = true, bool KCAT = false>
__device__ __forceinline__ void gemm_phase(PG8_LAS unsigned char* lds, const Sched& S, const Epi& E) {
    int tid = threadIdx.x; asm volatile("" : "+v"(tid));
    const int wid = __builtin_amdgcn_readfirstlane(tid >> 6), lane = tid & 63, wr = wid >> 2, wc = wid & 3, fr = lane & 15, fq = lane >> 4;
    unsigned voffA[2], voffB[2];
#pragma unroll
    for (int i = 0; i < 2; ++i) { int R, C; stage_rc(tid * 16 + i * 8192, R, C); const int Rb = Epi::PERM ? ((R & ~31) + perm32(R & 31)) : R;
        voffA[i] = (unsigned)(R * LDA + C) * 2u; voffB[i] = (unsigned)(Rb * LDB + C) * 2u; }
    const size_t kstep = (size_t)(BK * 2);
    constexpr size_t hstepA = (size_t)HALF * LDA * 2, hstepB = (size_t)HALF * LDB * 2;
    const unsigned ldsw = (unsigned)wid * 1024u;
    const int aoff = lds_byte(wr * 64 + fr, fq * 8), boff = lds_byte(wc * 32 + fr, fq * 8);
#define PG8_SA(b, h) (((b) * 2 + (h)) * HTB)
#define PG8_SB(b, h) ((4 + (b) * 2 + (h)) * HTB)
#define PG8_STAGE(bufoff, gbase, voff) do { _Pragma("unroll") for (int _i = 0; _i < 2; ++_i) \
        __builtin_amdgcn_global_load_lds((const unsigned*)((const char*)(gbase) + (voff)[_i]), (PG8_LAS unsigned*)(lds + (bufoff) + ldsw + _i * 8192), 16, 0, 0); } while (0)
#define PG8_LDA(dst, b, h) do { _Pragma("unroll") for (int m = 0; m < 4; ++m) _Pragma("unroll") for (int k = 0; k < 2; ++k) dst[m][k] = *(const PG8_LAS bf16x8*)(lds + PG8_SA(b, h) + aoff + m * 2048 + k * 1024); } while (0)
#define PG8_LDB(dst, b, h) do { _Pragma("unroll") for (int n = 0; n < 2; ++n) _Pragma("unroll") for (int k = 0; k < 2; ++k) dst[n][k] = *(const PG8_LAS bf16x8*)(lds + PG8_SB(b, h) + boff + n * 2048 + k * 1024); } while (0)
#define PG8_MMA(ai, bj, At, Bt) do { __builtin_amdgcn_s_setprio(1); _Pragma("unroll") for (int m = 0; m < 4; ++m) _Pragma("unroll") for (int n = 0; n < 2; ++n) _Pragma("unroll") for (int k = 0; k < 2; ++k) \
        acc[ai][bj][m][n] = __builtin_amdgcn_mfma_f32_16x16x32_bf16(Bt[n][k], At[m][k], acc[ai][bj][m][n], 0, 0, 0); __builtin_amdgcn_s_setprio(0); } while (0)
#define PG8_WAIT_V(n) asm volatile("s_waitcnt vmcnt(" #n ")" ::: "memory")
#define PG8_WAIT_L(n) asm volatile("s_waitcnt lgkmcnt(" #n ")" ::: "memory")
#define PG8_BAR __builtin_amdgcn_s_barrier()
#define PG8_SCHED __builtin_amdgcn_sched_barrier(0)
    Unit cur, nxt; int ui = 0;
    if (!S.next(0, cur)) return;
    f32x4 acc[2][2][4][2];
#pragma unroll
    for (int a = 0; a < 2; ++a)
#pragma unroll
        for (int b = 0; b < 2; ++b)
#pragma unroll
            for (int m = 0; m < 4; ++m)
#pragma unroll
                for (int n = 0; n < 2; ++n) acc[a][b][m][n] = (f32x4){0.f, 0.f, 0.f, 0.f};
    bf16x8 At[4][2], B0[2][2], B1[2][2];
    const char* cA = cur.A; const char* cB = cur.B;
    static_assert(SP2, "only the SP2 loop is kept");
    const char* pA0 = KCAT ? cA + kcat_off(0) : cA; const char* pA1 = KCAT ? cA + kcat_off(1) : cA + kstep;
    PG8_STAGE(PG8_SB(0, 0), cB, voffB); PG8_STAGE(PG8_SB(0, 1), cB + hstepB, voffB); PG8_STAGE(PG8_SA(0, 0), pA0, voffA); PG8_STAGE(PG8_SA(0, 1), pA0 + hstepA, voffA);
    if (wr == 1) PG8_BAR;
    PG8_WAIT_V(2); PG8_BAR;
    PG8_STAGE(PG8_SB(1, 0), cB + kstep, voffB); PG8_STAGE(PG8_SA(1, 0), pA1, voffA); PG8_STAGE(PG8_SB(1, 1), cB + hstepB + kstep, voffB);
    PG8_WAIT_V(6); PG8_BAR;
    for (;;) {
        const bool has_next = S.next(ui + 1, nxt);
        const char* nA = has_next ? nxt.A : cA; const char* nB = has_next ? nxt.B : cB;
        const int nt = cur.nt;
        for (int t = 0; t < nt; t += 2) {
            const bool last = (t == nt - 2);
            const char* a1; const char* a2; const char* a3;
            if constexpr (KCAT) { if (t == 8 || t == 16 || t == 22) E.rescale(acc, cur, t, wr, wc, fr, fq);
                a1 = cA + kcat_off(t + 1); a2 = last ? nA + kcat_off(0) : cA + kcat_off(t + 2); a3 = last ? nA + kcat_off(1) : cA + kcat_off(t + 3); }
            else { a1 = cA + (size_t)(t + 1) * kstep; a2 = last ? nA : cA + (size_t)(t + 2) * kstep; a3 = a2 + kstep; }
            const char* b2 = last ? nB : cB + (size_t)(t + 2) * kstep; const char* b3 = b2 + kstep;
            PG8_LDB(B0, 0, 0); PG8_LDB(B1, 0, 1); PG8_SCHED; PG8_LDA(At, 0, 0); PG8_STAGE(PG8_SA(1, 1), a1 + hstepA, voffA);
            PG8_WAIT_V(8); PG8_WAIT_L(0); PG8_BAR; PG8_MMA(0, 0, At, B0); PG8_MMA(0, 1, At, B1); PG8_BAR; PG8_SCHED;
            PG8_LDA(At, 0, 1); PG8_STAGE(PG8_SB(0, 0), b2, voffB); PG8_STAGE(PG8_SB(0, 1), b2 + hstepB, voffB); PG8_STAGE(PG8_SA(0, 0), a2, voffA);
            PG8_WAIT_V(8); PG8_WAIT_L(0); PG8_BAR; PG8_MMA(1, 0, At, B0); PG8_MMA(1, 1, At, B1); PG8_BAR; PG8_SCHED;
            PG8_LDB(B0, 1, 0); PG8_LDB(B1, 1, 1); PG8_SCHED; PG8_LDA(At, 1, 0); PG8_STAGE(PG8_SA(0, 1), a2 + hstepA, voffA);
            PG8_WAIT_V(8); PG8_WAIT_L(0); PG8_BAR; PG8_MMA(0, 0, At, B0); PG8_MMA(0, 1, At, B1); PG8_BAR; PG8_SCHED;
            PG8_LDA(At, 1, 1); PG8_STAGE(PG8_SB(1, 0), b3, voffB); PG8_STAGE(PG8_SB(1, 1), b3 + hstepB, voffB); PG8_STAGE(PG8_SA(1, 0), a3, voffA);
            PG8_WAIT_V(8); PG8_WAIT_L(0); PG8_BAR; PG8_MMA(1, 0, At, B0); PG8_MMA(1, 1, At, B1); PG8_BAR; PG8_SCHED;
        }
        if constexpr (ALIGN_EPI) { if (wr == 0) PG8_BAR; }
        E(acc, cur, wr, wc, fr, fq);
        if (!has_next) break;
#pragma unroll
        for (int a = 0; a < 2; ++a)
#pragma unroll
            for (int b = 0; b < 2; ++b)
#pragma unroll
                for (int m = 0; m < 4; ++m)
#pragma unroll
                    for (int n = 0; n < 2; ++n) acc[a][b][m][n] = (f32x4){0.f, 0.f, 0.f, 0.f};
        cur = nxt; cA = nA; cB = nB; ++ui;
        if constexpr (ALIGN_EPI) { if (wr == 1) PG8_BAR; }
    }
    PG8_WAIT_V(0);
    if constexpr (!ALIGN_EPI) { if (wr == 0) PG8_BAR; }
    PG8_BAR;
#undef PG8_SA
#undef PG8_SB
#undef PG8_STAGE
#undef PG8_LDA
#undef PG8_LDB
#undef PG8_MMA
#undef PG8_WAIT_V
#undef PG8_WAIT_L
#undef PG8_BAR
#undef PG8_SCHED
}
}

#define RLX_AGENT __ATOMIC_RELAXED, __HIP_MEMORY_SCOPE_AGENT
#define LDS_WAIT() asm volatile("s_waitcnt lgkmcnt(0)" ::: "memory")
#define VM_WAIT() asm volatile("s_waitcnt vmcnt(0)" ::: "memory")
typedef __bf16 bf16x2_t __attribute__((ext_vector_type(2)));
__device__ __forceinline__ unsigned pk2(float lo, float hi) { f32x2 v = {lo, hi}; bf16x2_t b = __builtin_convertvector(v, bf16x2_t); return __builtin_bit_cast(unsigned, b); }
__device__ __forceinline__ unsigned f2bf(float f) { return pk2(f, 0.f) & 0xffffu; }
__device__ __forceinline__ float bf2f(unsigned short h) { return __builtin_bit_cast(float, (unsigned)h << 16); }
__device__ __forceinline__ u32x4 zero4() { unsigned z = 0u; asm volatile("" : "+v"(z)); return (u32x4){z, z, z, z}; }
__device__ __forceinline__ float rcpf_(float x) { return __builtin_amdgcn_rcpf(x); }
__device__ __forceinline__ float sigmoidf_(float x) { return rcpf_(1.0f + __expf(-x)); }
__device__ __forceinline__ float siluf_(float x) { return x * rcpf_(1.0f + __expf(-x)); }

#define XB_TMO      128
#define XB_XCNT(j)  (256  + 64 * (j))
#define XB_XSUB(j)  (1280 + 64 * (j))
#define XB_XGEN(j)  (2304 + 64 * (j))
#define XB_TOP      3328
#define XB_TOPGEN   3392
#define XCD_BAR_WORDS 3456
#define XB_SPIN_CAP (1u << 18)
__device__ __forceinline__ unsigned xb_ld(unsigned* p)              { return __hip_atomic_load(p, __ATOMIC_RELAXED, __HIP_MEMORY_SCOPE_AGENT); }
__device__ __forceinline__ unsigned xb_add(unsigned* p, unsigned v) { return __hip_atomic_fetch_add(p, v, __ATOMIC_RELAXED, __HIP_MEMORY_SCOPE_AGENT); }
__device__ __forceinline__ unsigned xb_xcc_id() { return (unsigned)__builtin_amdgcn_s_getreg((3 << 11) | 20) & 0xFu; }
#define XB_SPIN(cond, bar) do { unsigned _sp = 0; while (cond) { __builtin_amdgcn_s_sleep(1); \
    if ((++_sp & 255u) == 0u) { if (xb_ld(&(bar)[XB_TMO])) break; if (_sp > XB_SPIN_CAP) { atomicAdd(&(bar)[XB_TMO], 1u); break; } } } } while (0)
struct XcdBarrier { unsigned* bar; unsigned x; volatile LAS unsigned* st; };
__device__ __forceinline__ XcdBarrier xcd_barrier_post(unsigned* bar, volatile LAS unsigned* st) {
    XcdBarrier b; b.bar = bar; b.x = xb_xcc_id(); b.st = st;
    if (threadIdx.x == 0) (void)xb_add(&bar[XB_XCNT(b.x)], 1u);
    return b;
}
__device__ __forceinline__ void xcd_barrier_complete(unsigned* bar, unsigned x, unsigned& nloc, unsigned& nx) {
    const unsigned G = gridDim.x * gridDim.y * gridDim.z;
    unsigned sum, cnt, mine, sp = 0u;
    for (;;) {
        sum = 0u; cnt = 0u; mine = 0u;
#pragma unroll
        for (unsigned j = 0; j < 16; ++j) { const unsigned c = xb_ld(&bar[XB_XCNT(j)]); sum += c; cnt += (c > 0u) ? 1u : 0u; mine = (j == x) ? c : mine; }
        if (sum == G) break;
        __builtin_amdgcn_s_sleep(1);
        if ((++sp & 255u) == 0u) { if (xb_ld(&bar[XB_TMO])) break; if (sp > XB_SPIN_CAP) { atomicAdd(&bar[XB_TMO], 1u); break; } }
    }
    nloc = mine > 0u ? mine : 1u; nx = cnt > 0u ? cnt : 1u;
}
__device__ __forceinline__ void xcd_barrier(const XcdBarrier& b) {
    asm volatile("s_waitcnt vmcnt(0)" ::: "memory");
    __syncthreads();
    if (threadIdx.x == 0) {
        unsigned* bar = b.bar;
        __builtin_amdgcn_s_waitcnt(0);
        unsigned nloc = b.st[0], nx = b.st[1];
        if (nloc == 0u) { xcd_barrier_complete(bar, b.x, nloc, nx); b.st[0] = nloc; b.st[1] = nx; }
        const unsigned old = xb_add(&bar[XB_XSUB(b.x)], 1u);
        const unsigned gen = old / nloc;
        if (old + 1u == (gen + 1u) * nloc) {
            __builtin_amdgcn_fence(__ATOMIC_RELEASE, "agent");
            asm volatile("s_waitcnt vmcnt(0)" ::: "memory");
            const unsigned og = xb_add(&bar[XB_TOP], 1u);
            const unsigned tg = og / nx;
            if (og + 1u == (tg + 1u) * nx) xb_add(&bar[XB_TOPGEN], 1u);
            else XB_SPIN(xb_ld(&bar[XB_TOPGEN]) == tg, bar);
            __builtin_amdgcn_fence(__ATOMIC_ACQUIRE, "agent");
            xb_add(&bar[XB_XGEN(b.x)], 1u);
            asm volatile("s_waitcnt vmcnt(0)" ::: "memory");
        } else {
            XB_SPIN(xb_ld(&bar[XB_XGEN(b.x)]) == gen, bar);
            __builtin_amdgcn_fence(__ATOMIC_ACQUIRE, "agent");
            asm volatile("s_waitcnt vmcnt(0)" ::: "memory");
        }
    }
    __syncthreads();
}

__device__ __forceinline__ float wave_sum(float v) {
#pragma unroll
    for (int o = 1; o < 64; o <<= 1) v += __shfl_xor(v, o);
    return v;
}

#define PHASE_IDS() int tid = threadIdx.x; asm volatile("" : "+v"(tid)); const int lane = tid & 63; const int wave = __builtin_amdgcn_readfirstlane(tid >> 6); (void)lane; (void)wave
struct Args { const float* in[N_IN]; float* out; unsigned char* ws; };
struct Frame {
    LAS unsigned char* lds;
    int vcu, G;
    const float* const* in;
    float* out; unsigned char* ws;
};
__device__ __forceinline__ const float* modp(Frame& F, int l, int mb, int k) { return (const float*)(F.ws + WS_MOD) + ((size_t)(l * 5 + mb) * 6 + k) * D; }
__device__ __forceinline__ int mb_of_tile(int pmg) { return pmg < 64 ? (pmg >> 4) : 4; }

__device__ __forceinline__ void p0_mods(Frame& F) {
    PHASE_IDS();
    LAS float* sc = (LAS float*)F.lds;
    LAS float* red = sc + 5 * D;
    for (int i = tid; i < 5 * D; i += NTHR) { const float v = i < 4 * D ? F.in[I_C][i] : F.in[I_CCTX][i - 4 * D]; sc[i] = siluf_(v); }
    __syncthreads();
    for (int item = F.vcu; item < 2 * 96; item += F.G) {
        const int l = item / 96, j = (item % 96) * 64 + lane;
        const float* W = F.in[I_WMOD] + (size_t)l * D * 6 * D + j;
        float a0 = 0.f, a1 = 0.f, a2 = 0.f, a3 = 0.f, a4 = 0.f;
        const int k0 = wave * 128;
#pragma unroll 32
        for (int k = k0; k < k0 + 128; ++k) { const float w = W[(size_t)k * 6 * D]; a0 += sc[k] * w; a1 += sc[D + k] * w; a2 += sc[2 * D + k] * w; a3 += sc[3 * D + k] * w; a4 += sc[4 * D + k] * w; }
        LAS float* r = red + wave * 320 + lane;
        r[0] = a0; r[64] = a1; r[128] = a2; r[192] = a3; r[256] = a4;
        __syncthreads();
        if (tid < 320) { const int mb = tid >> 6, jj = tid & 63; float s = 0.f;
#pragma unroll
            for (int w = 0; w < 8; ++w) s += red[w * 320 + mb * 64 + jj];
            const int jc = (item % 96) * 64 + jj;
            ((float*)(F.ws + WS_MOD))[(size_t)(l * 5 + mb) * 6 * D + jc] = s + F.in[I_BMOD][l * 6 * D + jc]; }
        __syncthreads();
    }
}

__device__ __forceinline__ void transpose_item(const float* W, int ldw, int k0, int srccol, bf16* WT, int Kt, int kdst0, int nrow0, LAS float* scr, int lane) {
    float tv[32];
#pragma unroll
    for (int i = 0; i < 32; ++i) { const int kk = 2 * i + (lane >> 5); tv[i] = srccol >= 0 ? W[(size_t)(k0 + kk) * ldw + srccol] : 0.f; }
#pragma unroll
    for (int i = 0; i < 32; ++i) { const int kk = 2 * i + (lane >> 5); scr[kk * 33 + (lane & 31)] = tv[i]; }
    LDS_WAIT(); asm volatile("" ::: "memory");
    const int c = lane & 7;
#pragma unroll
    for (int j = 0; j < 4; ++j) { const int n = (lane >> 3) + 8 * j; const LAS float* s = scr + (8 * c) * 33 + n;
        u32x4 o; o.x = pk2(s[0 * 33], s[1 * 33]); o.y = pk2(s[2 * 33], s[3 * 33]); o.z = pk2(s[4 * 33], s[5 * 33]); o.w = pk2(s[6 * 33], s[7 * 33]);
        *(u32x4*)(WT + (size_t)(nrow0 + n) * Kt + kdst0 + 8 * c) = o; }
    LDS_WAIT(); asm volatile("" ::: "memory");
}
__device__ __forceinline__ int win_src(int n) {
    if (n < 1536) return n;
    if (n < 1920) return 1552 + (n - 1536);
    if (n < 1936) return 1536 + (n - 1920);
    if (n < 2048) return -1;
    return 1936 + (n - 2048);
}
__device__ __forceinline__ void p0_weights(Frame& F, int l) {
    PHASE_IDS();
    LAS float* scr = (LAS float*)(F.lds + 32768 + wave * 8704);
    const int gw = F.vcu * NWAVES + wave, NGW = F.G * NWAVES;
    constexpr int I_IN = (ZW / 32) * (D / 64), I_UP = (D / 32) * (1920 / 64), I_OUT = (D / 32) * (D / 64), I_F1 = (FF2 / 32) * (D / 64), I_F2 = (D / 32) * (FFH / 64), I_GL = (384 / 32) * (384 / 64);
    constexpr int NITEMS = I_IN + I_UP + I_OUT + I_F1 + I_F2 + I_GL;
    const int ln = lane & 31;
    for (int it = gw; it < NITEMS; it += NGW) {
        int r = it;
        if (r < I_IN) { const int kb = r / (ZW / 32), nb = r % (ZW / 32);
            transpose_item(F.in[I_WIN] + (size_t)l * D * IN_DIM, IN_DIM, 64 * kb, win_src(32 * nb + ln), (bf16*)(F.ws + WS_WIN), D, 64 * kb, 32 * nb, scr, lane); continue; } r -= I_IN;
        if (r < I_UP) { const int kb = r / (D / 32), nb = r % (D / 32); const int kd = 64 * kb;
            const float* W; int ks;
            if (kd < 512) { W = F.in[I_WUPM] + (size_t)l * 512 * D; ks = kd; } else if (kd < 1024) { W = F.in[I_WUPSGU] + (size_t)l * 512 * D; ks = kd - 512; }
            else if (kd < 1408) { W = F.in[I_WUPS5] + (size_t)l * 384 * D; ks = kd - 1024; } else { W = F.in[I_WUPSC] + (size_t)l * 512 * D; ks = kd - 1408; }
            transpose_item(W, D, ks, 32 * nb + ln, (bf16*)(F.ws + WS_WUP), 1920, kd, 32 * nb, scr, lane); continue; } r -= I_UP;
        if (r < I_OUT) { const int kb = r / (D / 32), nb = r % (D / 32);
            transpose_item(F.in[I_WOUT] + (size_t)l * D * D, D, 64 * kb, 32 * nb + ln, (bf16*)(F.ws + WS_WOUT), D, 64 * kb, 32 * nb, scr, lane); continue; } r -= I_OUT;
        if (r < I_F1) { const int kb = r / (FF2 / 32), nb = r % (FF2 / 32); const int n0 = 32 * nb, pn = n0 >> 8, j = n0 & 255;
            const float* W = (j < 128 ? F.in[I_WFFG] : F.in[I_WFFU]) + (size_t)l * D * FFH;
            transpose_item(W, FFH, 64 * kb, 128 * pn + (j & 127) + ln, (bf16*)(F.ws + WS_WFF1), D, 64 * kb, n0, scr, lane); continue; } r -= I_F1;
        if (r < I_F2) { const int kb = r / (D / 32), nb = r % (D / 32);
            transpose_item(F.in[I_WFFD] + (size_t)l * FFH * D, D, 64 * kb, 32 * nb + ln, (bf16*)(F.ws + WS_WFF2), FFH, 64 * kb, 32 * nb, scr, lane); continue; } r -= I_F2;
        { const int kb = r / (384 / 32), nb = r % (384 / 32);
            transpose_item(F.in[I_WGLU] + (size_t)l * 384 * 384, 384, 64 * kb, 32 * nb + ln, (bf16*)(F.ws + WS_WGLU), 384, 64 * kb, 32 * nb, scr, lane); }
    }
}

__device__ __forceinline__ void norm_phase(Frame& F, const float* xl, const float* xc, const float* gn, int l, int si, int nrows) {
    PHASE_IDS();
    const int gw = F.vcu * NWAVES + wave, NGW = F.G * NWAVES;
    bf16* hn = (bf16*)(F.ws + WS_HN);
    f32x4 g4[4];
#pragma unroll
    for (int j = 0; j < 4; ++j) g4[j] = ((const f32x4*)gn)[lane + 64 * j];
    for (int R0 = gw; R0 < nrows; R0 += 2 * NGW) {
        f32x4 v[2][4], sc[2][4], sh[2][4];
#pragma unroll
        for (int q = 0; q < 2; ++q) { const int R = R0 + q * NGW; if (R < nrows) { const float* xrow = R < MLAT ? xl + (size_t)R * D : xc + (size_t)(R - MLAT) * D; const f32x4* xr = (const f32x4*)xrow + lane;
                const int mb = R < MLAT ? R / SEQ : 4; const f32x4* shp = (const f32x4*)modp(F, l, mb, si) + lane; const f32x4* scp = (const f32x4*)modp(F, l, mb, si + 1) + lane;
#pragma unroll
                for (int j = 0; j < 4; ++j) { v[q][j] = xr[64 * j]; sc[q][j] = scp[64 * j]; sh[q][j] = shp[64 * j]; } } }
        __builtin_amdgcn_sched_barrier(0);
#pragma unroll
        for (int q = 0; q < 2; ++q) { const int R = R0 + q * NGW; if (R < nrows) {
            float ss = 0.f;
#pragma unroll
            for (int j = 0; j < 4; ++j) ss += (v[q][j].x * v[q][j].x + v[q][j].y * v[q][j].y) + (v[q][j].z * v[q][j].z + v[q][j].w * v[q][j].w);
            const float rstd = __builtin_amdgcn_rsqf(wave_sum(ss) * (1.f / D) + RMS_EPS);
            unsigned long long* o8 = (unsigned long long*)(hn + (size_t)R * D) + lane;
#pragma unroll
            for (int j = 0; j < 4; ++j) { const f32x4 y = v[q][j] * rstd * g4[j] * (sc[q][j] + 1.0f) + sh[q][j];
                o8[64 * j] = (unsigned long long)pk2(y.x, y.y) | ((unsigned long long)pk2(y.z, y.w) << 32); } } }
    }
}
__device__ __forceinline__ void final_norm_phase(Frame& F) {
    PHASE_IDS();
    const int gw = F.vcu * NWAVES + wave, NGW = F.G * NWAVES;
    f32x4 g4[4];
#pragma unroll
    for (int j = 0; j < 4; ++j) g4[j] = ((const f32x4*)F.in[I_GFINAL])[lane + 64 * j];
    for (int R0 = gw; R0 < MLAT; R0 += 4 * NGW) {
        f32x4 v[4][4];
#pragma unroll
        for (int q = 0; q < 4; ++q) { const int R = R0 + q * NGW; if (R < MLAT) { const f32x4* xr = (const f32x4*)(F.out + (size_t)R * D) + lane;
#pragma unroll
                for (int j = 0; j < 4; ++j) v[q][j] = xr[64 * j]; } }
#pragma unroll
        for (int q = 0; q < 4; ++q) { const int R = R0 + q * NGW; if (R < MLAT) { float ss = 0.f;
#pragma unroll
            for (int j = 0; j < 4; ++j) ss += (v[q][j].x * v[q][j].x + v[q][j].y * v[q][j].y) + (v[q][j].z * v[q][j].z + v[q][j].w * v[q][j].w);
            const float rstd = __builtin_amdgcn_rsqf(wave_sum(ss) * (1.f / D) + RMS_EPS);
            f32x4* xr = (f32x4*)(F.out + (size_t)R * D) + lane;
#pragma unroll
            for (int j = 0; j < 4; ++j) xr[64 * j] = v[q][j] * rstd * g4[j]; } }
    }
}

struct EpiResid {
    static constexpr bool PERM = false;
    const float* base_l; const float* base_c; float* out_l; float* out_c; const float* mod;
    __device__ __forceinline__ void operator()(const f32x4 (&acc)[2][2][4][2], const pg8::Unit& u, int wr, int wc, int fr, int fq) const {
        const int pmg = u.pmg; const bool isc = pmg >= 64;
        const float* base = isc ? base_c + (size_t)(pmg - 64) * 256 * D : base_l + (size_t)pmg * 256 * D;
        float* out = isc ? out_c + (size_t)(pmg - 64) * 256 * D : out_l + (size_t)pmg * 256 * D;
        const float* mv = mod + (size_t)mb_of_tile(pmg) * 6 * D;
        const int row0 = wr * 64 + fr, col0 = u.pn * 256 + wc * 32 + 4 * fq;
#pragma unroll
        for (int ai = 0; ai < 2; ++ai)
#pragma unroll
            for (int m = 0; m < 4; ++m) { const size_t off = (size_t)(row0 + ai * 128 + m * 16) * D + col0;
                f32x4 b4[2][2], mv4[2][2];
#pragma unroll
                for (int bj = 0; bj < 2; ++bj)
#pragma unroll
                    for (int n = 0; n < 2; ++n) { b4[bj][n] = *(const f32x4*)(base + off + bj * 128 + n * 16); mv4[bj][n] = *(const f32x4*)(mv + col0 + bj * 128 + n * 16); }
                __builtin_amdgcn_sched_barrier(0);
#pragma unroll
                for (int bj = 0; bj < 2; ++bj)
#pragma unroll
                    for (int n = 0; n < 2; ++n) *(f32x4*)(out + off + bj * 128 + n * 16) = b4[bj][n] + mv4[bj][n] * acc[ai][bj][m][n];
                asm volatile("" ::: "memory"); }
    }
};
struct EpiSwiglu {
    static constexpr bool PERM = true;
    bf16* H;
    __device__ __forceinline__ void operator()(const f32x4 (&acc)[2][2][4][2], const pg8::Unit& u, int wr, int wc, int fr, int fq) const {
        const int row0 = u.pmg * 256 + wr * 64 + fr, col0 = u.pn * 128 + wc * 32 + 8 * fq;
#pragma unroll
        for (int ai = 0; ai < 2; ++ai)
#pragma unroll
            for (int m = 0; m < 4; ++m) { bf16* p = H + (size_t)(row0 + ai * 128 + m * 16) * FFH + col0;
                const f32x4 g0 = acc[ai][0][m][0], g1 = acc[ai][0][m][1], u0 = acc[ai][1][m][0], u1 = acc[ai][1][m][1];
                u32x4 w; w.x = pk2(siluf_(g0[0]) * u0[0], siluf_(g0[1]) * u0[1]); w.y = pk2(siluf_(g0[2]) * u0[2], siluf_(g0[3]) * u0[3]);
                w.z = pk2(siluf_(g1[0]) * u1[0], siluf_(g1[1]) * u1[1]); w.w = pk2(siluf_(g1[2]) * u1[2], siluf_(g1[3]) * u1[3]);
                *(u32x4*)p = w; }
    }
};
struct OrderGlobal {
    const char* A; const char* B; int lda, ldb, nM, nN, nt, G, c;
    __device__ __forceinline__ bool next(int i, pg8::Unit& u) const {
        const int L = i * G + c; if (L >= nM * nN) return false;
        int pm, pn; pg8::tile_of(L, nM, nN, pm, pn);
        u.pm = pm; u.pn = pn; u.pmg = pm; u.br = 0; u.nt = nt;
        u.A = A + (size_t)pm * 256 * lda * 2; u.B = B + (size_t)pn * 256 * ldb * 2; return true;
    }
};


constexpr int ZC_Q = 0, ZC_K = 512, ZC_V = 1024, ZC_U = 1536, ZC_G = 1920, ZC_O = 2048, ZC_SU = 2560, ZC_SV = 3072, ZC_CB = 3584, ZC_CC = 4096, ZC_CX = 4608, ZC_BG = 5120;
constexpr int LDT = 136;
constexpr int NLC = 68;
constexpr size_t MS_NST = 0, MS_SC = 512 * 1024, MS_S5X = 1 * MiB;
constexpr size_t S5T_AB = 0, S5T_BB = 73728, S5T_CC = S5T_BB + 2 * 24 * 8 * 64 * 16;
__device__ __forceinline__ float geluf_(float x) { const float z = 1.5957691216f * (x + 0.044715f * x * x * x); return x * rcpf_(1.0f + __expf(-z)); }
__device__ __forceinline__ float logsigf_(float f) { return fminf(f, 0.f) - log1pf(__expf(-fabsf(f))); }
__device__ __forceinline__ int gtile_of(int g, int pm_l) { return pm_l < 32 ? g * 32 + pm_l : 64 + g * 2 + (pm_l - 32); }
__device__ __forceinline__ float bflo(unsigned w) { return __builtin_bit_cast(float, w << 16); }
__device__ __forceinline__ float bfhi(unsigned w) { return __builtin_bit_cast(float, w & 0xffff0000u); }
__device__ __forceinline__ int chain_lc(int b, int dir, int k) { return k < 2 ? 64 + 2 * b + (dir ? 1 - k : k) : 32 * b + (dir ? 31 - (k - 2) : (k - 2)); }

template <int NT, int KS>
__device__ __forceinline__ void mm_lds(f32x4 (&acc)[NT], const LAS bf16* A, int lda, const LAS bf16* BT, int ldb, int bclamp, int lane) {
    const int r = lane & 15, kq = lane >> 4;
#pragma unroll
    for (int ks = 0; ks < KS; ++ks) {
        const bf16x8 a = *(const LAS bf16x8*)(A + r * lda + ks * 32 + kq * 8);
        bf16x8 b[NT];
#pragma unroll
        for (int n = 0; n < NT; ++n) { int br = n * 16 + r; br = br > bclamp ? bclamp : br; b[n] = *(const LAS bf16x8*)(BT + br * ldb + ks * 32 + kq * 8); }
#pragma unroll
        for (int n = 0; n < NT; ++n) acc[n] = __builtin_amdgcn_mfma_f32_16x16x32_bf16(a, b[n], acc[n], 0, 0, 0);
    }
}
typedef short v4i16_t __attribute__((ext_vector_type(4)));
__device__ __forceinline__ bf16x8 frag_tr(const LAS bf16* T, int ld, int k0, int n0, int lane) {
    const int g = lane >> 4, q = (lane & 15) >> 2, p = lane & 3;
    const LAS bf16* a = T + (k0 + 8 * g + q) * ld + n0 + 4 * p;
    const v4i16_t lo = __builtin_amdgcn_ds_read_tr16_b64_v4i16((LAS v4i16_t*)a);
    const v4i16_t hi = __builtin_amdgcn_ds_read_tr16_b64_v4i16((LAS v4i16_t*)(a + 4 * ld));
    return (bf16x8){lo[0], lo[1], lo[2], lo[3], hi[0], hi[1], hi[2], hi[3]};
}
template <int NT, int KS>
__device__ __forceinline__ void mm_nn(f32x4 (&acc)[NT], const LAS bf16* A, int lda, const LAS bf16* B, int ldb, int lane) {
    const int r = lane & 15, kq = lane >> 4;
#pragma unroll
    for (int ks = 0; ks < KS; ++ks) {
        const bf16x8 a = *(const LAS bf16x8*)(A + r * lda + ks * 32 + kq * 8);
        bf16x8 b[NT];
#pragma unroll
        for (int n = 0; n < NT; ++n) b[n] = frag_tr(B, ldb, ks * 32, n * 16, lane);
#pragma unroll
        for (int n = 0; n < NT; ++n) acc[n] = __builtin_amdgcn_mfma_f32_16x16x32_bf16(a, b[n], acc[n], 0, 0, 0);
    }
}
__device__ __forceinline__ void scan_max2(float a, float b, int lane, float& m0, float& m1) {
    float s = fmaxf(a, b);
#pragma unroll
    for (int o = 1; o < 64; o <<= 1) { const float t = __shfl_up(s, o); if (lane >= o) s = fmaxf(s, t); }
    float ex = __shfl_up(s, 1); if (lane == 0) ex = -INFINITY;
    m0 = fmaxf(ex, a); m1 = s;
}
__device__ __forceinline__ float grp16_max(float v) { v = fmaxf(v, __shfl_xor(v, 1)); v = fmaxf(v, __shfl_xor(v, 2)); v = fmaxf(v, __shfl_xor(v, 4)); v = fmaxf(v, __shfl_xor(v, 8)); return v; }
__device__ __forceinline__ float grp16_sum(float v) { v += __shfl_xor(v, 1); v += __shfl_xor(v, 2); v += __shfl_xor(v, 4); v += __shfl_xor(v, 8); return v; }

__device__ __forceinline__ void mlstm_gates(Frame& F, int l, const bf16* zx, int lc, int h, int d, int p, float& lf, float& ip) {
    const bf16* row = zx + (size_t)(lc * 128 + p) * ZW + ZC_G; const float* bg = F.in[I_BGATES] + l * 16;
    ip = bf2f(row[(2 * d) * 4 + h]) + bg[(2 * d) * 4 + h];
    lf = logsigf_(bf2f(row[(2 * d + 1) * 4 + h]) + bg[(2 * d + 1) * 4 + h]);
}
__device__ __forceinline__ float mlstm_scan128(LAS float* cum, int d, int lane, float& c0, float& c1, int& i0, int& i1) {
    i0 = d ? 127 - 2 * lane : 2 * lane; i1 = d ? 126 - 2 * lane : 2 * lane + 1;
    const float a = cum[i0], b = cum[i1]; float s = a + b;
#pragma unroll
    for (int o = 1; o < 64; o <<= 1) { const float t = __shfl_up(s, o); if (lane >= o) s += t; }
    c1 = s; c0 = s - b; cum[i0] = c0; cum[i1] = c1;
    return __shfl(s, 63);
}
__device__ __forceinline__ void qk_conv2(const bf16* zx, const float* wc  , int lr, int col, bool hl, bool hr, float& y0, float& y1) {
    const unsigned c = *(const unsigned*)(zx + (size_t)lr * ZW + col);
    const unsigned a = hl ? *(const unsigned*)(zx + (size_t)(lr - 1) * ZW + col) : 0u;
    const unsigned b = hr ? *(const unsigned*)(zx + (size_t)(lr + 1) * ZW + col) : 0u;
    const int ch = col & 511;
    y0 = siluf_(wc[ch] * bflo(a) + wc[512 + ch] * bflo(c) + wc[1024 + ch] * bflo(b));
    y1 = siluf_(wc[ch + 1] * bfhi(a) + wc[512 + ch + 1] * bfhi(c) + wc[1024 + ch + 1] * bfhi(b));
}
__device__ __forceinline__ void nbr_flags(int lc, int s, bool& hl, bool& hr) {
    if (lc < 64) { hl = (s & 63) != 0; hr = (s & 63) != 63; } else { const int t = ((lc - 64) & 1) * 128 + s; hl = t != 0; hr = t != 255; }
}

__device__ __forceinline__ void qk_conv8(const u32x4 a, const u32x4 c, const u32x4 b, const float* w  , float scale, u32x4& o) {
    float y[8];
#pragma unroll
    for (int e = 0; e < 4; ++e) {
        y[2 * e] = siluf_(w[2 * e] * bflo(a[e]) + w[8 + 2 * e] * bflo(c[e]) + w[16 + 2 * e] * bflo(b[e])) * scale;
        y[2 * e + 1] = siluf_(w[2 * e + 1] * bfhi(a[e]) + w[8 + 2 * e + 1] * bfhi(c[e]) + w[16 + 2 * e + 1] * bfhi(b[e])) * scale; }
    o = (u32x4){pk2(y[0], y[1]), pk2(y[2], y[3]), pk2(y[4], y[5]), pk2(y[6], y[7])};
}
__device__ __forceinline__ void qk_conv_rows(const bf16* zx, const float* wc, int lc, int rg, int colb, int ch0, float scale, u32x4 (&out)[4]) {
    float w[24];
#pragma unroll
    for (int j = 0; j < 3; ++j) { const f32x4 w0 = *(const f32x4*)(wc + j * 512 + ch0), w1 = *(const f32x4*)(wc + j * 512 + ch0 + 4);
#pragma unroll
        for (int e = 0; e < 4; ++e) { w[j * 8 + e] = w0[e]; w[j * 8 + 4 + e] = w1[e]; } }
    const int s0 = 4 * rg; bool hl, hr, d0, d1; nbr_flags(lc, s0, hl, d0); nbr_flags(lc, s0 + 3, d1, hr);
    const bf16* p = zx + (size_t)(lc * 128 + s0) * ZW + colb + ch0;
    u32x4 r[6];
    const u32x4 zz = zero4();
    r[0] = hl ? *(const u32x4*)(p - ZW) : zz;
#pragma unroll
    for (int i = 0; i < 4; ++i) r[1 + i] = *(const u32x4*)(p + (size_t)i * ZW);
    r[5] = hr ? *(const u32x4*)(p + (size_t)4 * ZW) : zz;
#pragma unroll
    for (int i = 0; i < 4; ++i) qk_conv8(r[i], r[i + 1], r[i + 2], w, scale, out[i]);
}
__device__ __forceinline__ void mlstm_local_item(Frame& F, int l, int lc, int h) {
    PHASE_IDS();
    bf16* zx = (bf16*)(F.ws + WS_ZX);
    LAS bf16* KP = (LAS bf16*)F.lds; LAS bf16* VF = KP + 128 * LDT; LAS bf16* VB = VF + 128 * LDT;
    LAS float* lfc = (LAS float*)(F.lds + 104448); LAS float* ipa = lfc + 256; LAS float* wa = ipa + 256;
    LAS bf16* wh = (LAS bf16*)(wa + 256);
    float* SCb = (float*)(F.ws + WS_MISC + MS_SC);
    __syncthreads();
    if (tid < 256) { const int d = tid >> 7, p = tid & 127; float lf, ip; mlstm_gates(F, l, zx, lc, h, d, p, lf, ip); lfc[tid] = lf; ipa[tid] = ip; }
    __syncthreads();
    if (wave < 2) { const int d = wave;
        float c0, c1; int i0, i1; const float tot = mlstm_scan128(lfc + d * 128, d, lane, c0, c1, i0, i1);
        const float l0 = tot - c0 + ipa[d * 128 + i0], l1 = tot - c1 + ipa[d * 128 + i1];
        float m = fmaxf(l0, l1);
#pragma unroll
        for (int o = 1; o < 64; o <<= 1) m = fmaxf(m, __shfl_xor(m, o));
        const float w0 = __expf(l0 - m), w1 = __expf(l1 - m);
        wa[d * 128 + i0] = w0; wa[d * 128 + i1] = w1; wh[d * 128 + i0] = (bf16)f2bf(w0); wh[d * 128 + i1] = (bf16)f2bf(w1);
        if (lane == 0) { float* SC = SCb + ((lc * 4 + h) * 2 + d) * 4; SC[0] = m; SC[1] = tot; }
    }
    const int rg = tid >> 4, ch0 = (tid & 15) * 8;
    const float* wcq = F.in[I_WCONVQK] + (size_t)(l * 2) * 3 * 512 + h * 128; const float* wck = wcq + 3 * 512;
    u32x4 qo[4], ko[4], vv[4];
    qk_conv_rows(zx, wcq, lc, rg, ZC_Q + h * 128, ch0, 1.0f, qo);
    qk_conv_rows(zx, wck, lc, rg, ZC_K + h * 128, ch0, 0.08838834764831845f, ko);
#pragma unroll
    for (int i = 0; i < 4; ++i) vv[i] = *(const u32x4*)(zx + (size_t)(lc * 128 + 4 * rg + i) * ZW + ZC_V + h * 128 + ch0);
    __syncthreads();
#pragma unroll
    for (int i = 0; i < 4; ++i) { const int s = 4 * rg + i;
        *(LAS u32x4*)(KP + s * LDT + ch0) = ko[i];
        const float wf = wa[s], wb = wa[128 + s]; u32x4 f, b;
#pragma unroll
        for (int e = 0; e < 4; ++e) { const float lo = bflo(vv[i][e]), hi = bfhi(vv[i][e]); f[e] = pk2(lo * wf, hi * wf); b[e] = pk2(lo * wb, hi * wb); }
        *(LAS u32x4*)(VF + s * LDT + ch0) = f; *(LAS u32x4*)(VB + s * LDT + ch0) = b;
        if (lc < 64) { bf16* zr = zx + (size_t)(lc * 128 + s) * ZW + h * 128 + ch0; *(u32x4*)(zr + ZC_Q) = qo[i]; *(u32x4*)(zr + ZC_K) = ko[i]; } }
    __syncthreads();
    f32x4 accf[9], accb[9];
#pragma unroll
    for (int n = 0; n < 9; ++n) { accf[n] = (f32x4){0.f, 0.f, 0.f, 0.f}; accb[n] = (f32x4){0.f, 0.f, 0.f, 0.f}; }
#pragma unroll
    for (int ks = 0; ks < 4; ++ks) {
        const bf16x8 a = frag_tr(KP, LDT, ks * 32, wave * 16, lane);
        const bf16x8 wfv = *(const LAS bf16x8*)(wh + ks * 32 + (lane >> 4) * 8), wbv = *(const LAS bf16x8*)(wh + 128 + ks * 32 + (lane >> 4) * 8);
        { bf16x8 bfr[8];
#pragma unroll
            for (int n = 0; n < 8; ++n) bfr[n] = frag_tr(VF, LDT, ks * 32, n * 16, lane);
#pragma unroll
            for (int n = 0; n < 8; ++n) accf[n] = __builtin_amdgcn_mfma_f32_16x16x32_bf16(a, bfr[n], accf[n], 0, 0, 0);
#pragma unroll
            for (int n = 0; n < 8; ++n) bfr[n] = frag_tr(VB, LDT, ks * 32, n * 16, lane);
#pragma unroll
            for (int n = 0; n < 8; ++n) accb[n] = __builtin_amdgcn_mfma_f32_16x16x32_bf16(a, bfr[n], accb[n], 0, 0, 0); }
        accf[8] = __builtin_amdgcn_mfma_f32_16x16x32_bf16(a, wfv, accf[8], 0, 0, 0); accb[8] = __builtin_amdgcn_mfma_f32_16x16x32_bf16(a, wbv, accb[8], 0, 0, 0);
    }
    const int r0 = wave * 16 + (lane >> 4) * 4, cc = lane & 15;
    __syncthreads();
#pragma unroll
    for (int n = 0; n < 8; ++n)
#pragma unroll
        for (int i = 0; i < 4; ++i) { KP[(r0 + i) * LDT + n * 16 + cc] = (bf16)f2bf(accf[n][i]); VF[(r0 + i) * LDT + n * 16 + cc] = (bf16)f2bf(accb[n][i]); }
    if (cc == 0) {
#pragma unroll
        for (int d = 0; d < 2; ++d) { float* NST = (float*)(F.ws + WS_MISC + MS_NST) + ((lc * 4 + h) * 2 + d) * 128;
#pragma unroll
            for (int i = 0; i < 4; ++i) NST[r0 + i] = d ? accb[8][i] : accf[8][i]; } }
    __syncthreads();
#pragma unroll
    for (int q = 0; q < 8; ++q) { const int idx = q * 512 + tid, d = idx >> 11, r = (idx >> 4) & 127, e0 = (idx & 15) * 8;
        bf16* MST = (bf16*)(F.ws + WS_MST) + (size_t)((lc * 4 + h) * 2 + d) * 16384;
        *(u32x4*)(MST + r * 128 + e0) = *(const LAS u32x4*)((d ? VF : KP) + r * LDT + e0); }
}

__device__ __forceinline__ void cmul(float& xr, float& xi, float ar, float ai) { const float r = ar * xr - ai * xi, i = ar * xi + ai * xr; xr = r; xi = i; }
__device__ __forceinline__ void s5_tables(Frame& F, int l) {
    PHASE_IDS();
    unsigned char* T = F.ws + WS_S5T;
    for (int idx = F.vcu * NTHR + tid; idx < 2 * 24 * 64; idx += F.G * NTHR) {
        const int dir = idx / 1536, g5 = (idx % 1536) >> 6, p = idx & 63;
        const int ix = ((l * 2 + dir) * 24 + g5) * 64 + p;
        const float are = F.in[I_S5ARE][ix], aim = F.in[I_S5AIM][ix];
        const float dt = __expf(F.in[I_S5LOGDT][(l * 2 + dir) * 24 + g5]);
        const float mag = __expf(dt * are); float rev = dt * aim * 0.15915494309189535f; rev -= floorf(rev);
        const float ab_re = mag * __builtin_amdgcn_cosf(rev), ab_im = mag * __builtin_amdgcn_sinf(rev);
        float pr = ab_re, pi = ab_im;
#pragma unroll
        for (int q = 0; q < 5; ++q) { const float r = pr * pr - pi * pi, i = 2.f * pr * pi; pr = r; pi = i; }
        const float a32r = pr, a32i = pi;
#pragma unroll
        for (int q = 0; q < 2; ++q) { const float r = pr * pr - pi * pi, i = 2.f * pr * pi; pr = r; pi = i; }
        float* ab = (float*)(T + S5T_AB) + (size_t)idx * 6;
        ab[0] = ab_re; ab[1] = ab_im; ab[2] = a32r; ab[3] = a32i; ab[4] = pr; ab[5] = pi;
        const float nr = ab_re - 1.0f, ni = ab_im, den = rcpf_(are * are + aim * aim);
        const float f_re = (nr * are + ni * aim) * den, f_im = (ni * are - nr * aim) * den;
        const f32x4* br = (const f32x4*)(F.in[I_S5BRE] + ((size_t)(l * 24 + g5) * 64 + p) * 16); const f32x4* bi = (const f32x4*)(F.in[I_S5BIM] + ((size_t)(l * 24 + g5) * 64 + p) * 16);
        float bbr[16], bbi[16];
#pragma unroll
        for (int q = 0; q < 4; ++q) { const f32x4 r = br[q], i = bi[q];
#pragma unroll
            for (int e = 0; e < 4; ++e) { bbr[q * 4 + e] = f_re * r[e] - f_im * i[e]; bbi[q * 4 + e] = f_re * i[e] + f_im * r[e]; } }
        u32x4* bb = (u32x4*)(T + S5T_BB) + (size_t)(dir * 24 + g5) * 8 * 64;
        const int pt = p >> 3, cc = (2 * p) & 15;
#pragma unroll
        for (int g = 0; g < 4; ++g) {
            u32x4 vr = (u32x4){0u, 0u, 0u, 0u}, vi = vr;
            if (g < 2) { vr = (u32x4){pk2(bbr[8 * g], bbr[8 * g + 1]), pk2(bbr[8 * g + 2], bbr[8 * g + 3]), pk2(bbr[8 * g + 4], bbr[8 * g + 5]), pk2(bbr[8 * g + 6], bbr[8 * g + 7])};
                         vi = (u32x4){pk2(bbi[8 * g], bbi[8 * g + 1]), pk2(bbi[8 * g + 2], bbi[8 * g + 3]), pk2(bbi[8 * g + 4], bbi[8 * g + 5]), pk2(bbi[8 * g + 6], bbi[8 * g + 7])}; }
            bb[pt * 64 + g * 16 + cc] = vr; bb[pt * 64 + g * 16 + cc + 1] = vi; }
    }
    for (int idx = F.vcu * NTHR + tid; idx < 24 * 4 * 64; idx += F.G * NTHR) {
        const int g5 = idx >> 8, ks = (idx >> 6) & 3, ln = idx & 63, j = ln & 15, k = ks * 32 + (ln >> 4) * 8, p0 = k >> 1;
        const f32x4 cr = *(const f32x4*)(F.in[I_S5CRE] + ((size_t)(l * 24 + g5) * 16 + j) * 64 + p0), ci = *(const f32x4*)(F.in[I_S5CIM] + ((size_t)(l * 24 + g5) * 16 + j) * 64 + p0);
        ((u32x4*)(T + S5T_CC))[idx] = (u32x4){pk2(cr[0], -ci[0]), pk2(cr[1], -ci[1]), pk2(cr[2], -ci[2]), pk2(cr[3], -ci[3])};
    }
}
__device__ __forceinline__ void s5_drive32(const u32x4 (&bb)[8]  , const LAS bf16* U16, LAS bf16* BU, int lane) {
    const bf16x8 b0 = *(const LAS bf16x8*)(U16 + (lane & 15) * 32 + (lane >> 4) * 8), b1 = *(const LAS bf16x8*)(U16 + (16 + (lane & 15)) * 32 + (lane >> 4) * 8);
#pragma unroll
    for (int pt = 0; pt < 8; ++pt) {
        const bf16x8 a = __builtin_bit_cast(bf16x8, bb[pt]);
        const f32x4 z = (f32x4){0.f, 0.f, 0.f, 0.f};
        const f32x4 o0 = __builtin_amdgcn_mfma_f32_16x16x32_bf16(a, b0, z, 0, 0, 0), o1 = __builtin_amdgcn_mfma_f32_16x16x32_bf16(a, b1, z, 0, 0, 0);
        *(LAS u32x2*)(BU + (lane & 15) * LDT + pt * 16 + (lane >> 4) * 4) = (u32x2){pk2(o0[0], o0[1]), pk2(o0[2], o0[3])};
        *(LAS u32x2*)(BU + (16 + (lane & 15)) * LDT + pt * 16 + (lane >> 4) * 4) = (u32x2){pk2(o1[0], o1[1]), pk2(o1[2], o1[3])};
    }
}
__device__ __forceinline__ void s5_local_item(Frame& F, int l, int lc, int sub) {
    PHASE_IDS();
    const bf16* zx = (const bf16*)(F.ws + WS_ZX);
    const int wt = sub * 8 + wave, g5 = wt >> 1, dir = wt & 1, p = lane;
    LAS bf16* U16 = (LAS bf16*)(F.lds + wave * 16896); LAS bf16* BU = U16 + 128 * 32;
    __syncthreads();
    const float* abp = (const float*)(F.ws + WS_S5T + S5T_AB) + (size_t)((dir * 24 + g5) * 64 + p) * 6;
    const float ab_re = abp[0], ab_im = abp[1];
    const u32x4* bbf = (const u32x4*)(F.ws + WS_S5T + S5T_BB) + (size_t)(dir * 24 + g5) * 8 * 64;
    u32x4 bb[8];
#pragma unroll
    for (int pt = 0; pt < 8; ++pt) bb[pt] = bbf[pt * 64 + lane];
    { u32x4 uu[4];
#pragma unroll
        for (int i = 0; i < 4; ++i) { const int c = i * 64 + lane, t = c >> 1, h8 = (c & 1) * 8; uu[i] = *(const u32x4*)(zx + (size_t)(lc * 128 + t) * ZW + ZC_U + g5 * 16 + h8); }
        const u32x4 z4 = zero4();
#pragma unroll
        for (int i = 0; i < 4; ++i) { const int c = i * 64 + lane, t = c >> 1, h8 = (c & 1) * 8; *(LAS u32x4*)(U16 + t * 32 + h8) = uu[i]; *(LAS u32x4*)(U16 + t * 32 + 16 + h8) = z4; } }
    LDS_WAIT(); asm volatile("" ::: "memory");
    float xr = 0.f, xi = 0.f;
    f32x2* E = (f32x2*)(F.ws + WS_S5E);
#pragma unroll 1
    for (int qq = 0; qq < 4; ++qq) {
        const int q = dir ? 3 - qq : qq;
        s5_drive32(bb, U16 + q * 32 * 32, BU, lane);
        LDS_WAIT(); asm volatile("" ::: "memory");
        unsigned wv[32];
#pragma unroll
        for (int k = 0; k < 32; ++k) { const int tl = dir ? 31 - k : k; wv[k] = *(const LAS unsigned*)(BU + tl * LDT + 2 * p); }
#pragma unroll
        for (int k = 0; k < 32; ++k) { const float bur = bflo(wv[k]), bui = bfhi(wv[k]);
            const float nr = ab_re * xr - ab_im * xi + bur, ni = ab_re * xi + ab_im * xr + bui; xr = nr; xi = ni; }
        E[((size_t)((lc * 2 + dir) * 4 + qq) * 24 + g5) * 64 + p] = (f32x2){xr, xi};
        LDS_WAIT(); asm volatile("" ::: "memory");
    }
}

__device__ __forceinline__ void scan_phase(Frame& F, int l) {
    PHASE_IDS();
    float* SCb = (float*)(F.ws + WS_MISC + MS_SC);
    for (int w = F.vcu; w < 256; w += F.G) {
        const int chain = w >> 4, blk = w & 15, b = chain >> 3, h = (chain >> 1) & 3, d = chain & 1;
        bf16* MSTb = (bf16*)(F.ws + WS_MST) + blk * 1024 + tid * 2;
        f32x2 v[34], sv[34];
#pragma unroll
        for (int k = 0; k < 34; ++k) { const int it = (chain_lc(b, d, k) * 4 + h) * 2 + d; const unsigned w2 = *(const unsigned*)(MSTb + (size_t)it * 16384); v[k] = (f32x2){bflo(w2), bfhi(w2)}; sv[k] = *(const f32x2*)(SCb + it * 4); }
        float zf = 0.f; asm volatile("" : "+v"(zf));
        float m = 0.f; f32x2 carry = (f32x2){zf, zf};
#pragma unroll
        for (int k = 0; k < 34; ++k) { const int it = (chain_lc(b, d, k) * 4 + h) * 2 + d;
            const float ml = sv[k].x, bl = sv[k].y, mn = fmaxf(bl + m, ml), dec = __expf(bl + m - mn), sc = __expf(ml - mn);
            *(unsigned*)(MSTb + (size_t)it * 16384) = pk2(carry.x, carry.y); carry = carry * dec + v[k] * sc;
            if (blk == 0 && tid == 0) SCb[it * 4 + 2] = m;
            m = mn; }
        if (blk == 1 && tid < 128) {
            float* NSTb = (float*)(F.ws + WS_MISC + MS_NST) + tid; float nv[34]; f32x2 sn[34];
#pragma unroll
            for (int k = 0; k < 34; ++k) { const int it = (chain_lc(b, d, k) * 4 + h) * 2 + d; nv[k] = NSTb[it * 128]; sn[k] = *(const f32x2*)(SCb + it * 4); }
            float mm = 0.f, cn = 0.f; asm volatile("" : "+v"(cn));
#pragma unroll
            for (int k = 0; k < 34; ++k) { const int it = (chain_lc(b, d, k) * 4 + h) * 2 + d;
                const float ml = sn[k].x, bl = sn[k].y, mn = fmaxf(bl + mm, ml), dec = __expf(bl + mm - mn), sc = __expf(ml - mn);
                NSTb[it * 128] = cn; cn = cn * dec + nv[k] * sc; mm = mn; }
        }
    }
    for (int w = F.vcu; w < 12; w += F.G) {
        const int gid = w * 512 + tid, b = gid / 3072, rem = gid % 3072, dir = rem / 1536, g5 = (rem % 1536) >> 6, p = rem & 63;
        const float* abp = (const float*)(F.ws + WS_S5T + S5T_AB) + (size_t)((dir * 24 + g5) * 64 + p) * 6; const float ar = abp[4], ai = abp[5];
        const f32x2* E = (const f32x2*)(F.ws + WS_S5E); f32x2* X = (f32x2*)(F.ws + WS_MISC + MS_S5X);
        f32x2 e[34];
#pragma unroll
        for (int k = 0; k < 34; ++k) { const int lc = chain_lc(b, dir, k); e[k] = E[((size_t)((lc * 2 + dir) * 4 + 3) * 24 + g5) * 64 + p]; }
        float xr = 0.f; asm volatile("" : "+v"(xr)); float xi = xr;
#pragma unroll
        for (int k = 0; k < 34; ++k) { const int lc = chain_lc(b, dir, k); X[((size_t)(lc * 2 + dir) * 24 + g5) * 64 + p] = (f32x2){xr, xi};
            cmul(xr, xi, ar, ai); xr += e[k].x; xi += e[k].y; }
    }
}

__device__ __forceinline__ void mlstm_out_item(Frame& F, int l, int lc, int h) {
    PHASE_IDS();
    bf16* zx = (bf16*)(F.ws + WS_ZX);
    LAS bf16* Q = (LAS bf16*)F.lds; LAS bf16* KS = Q + 128 * LDT; LAS bf16* V = KS + 128 * LDT; LAS bf16* C = V + 128 * LDT;
    LAS float* gs = (LAS float*)(F.lds + 139264); LAS float* mm = gs + 256; LAS float* mt = mm + 256;
    LAS bf16* nv = (LAS bf16*)(mt + 256);
    const float* SCb = (const float*)(F.ws + WS_MISC + MS_SC);
    __syncthreads();
    if (tid < 256) { const int d = tid >> 7, p = tid & 127; float lf, ip; mlstm_gates(F, l, zx, lc, h, d, p, lf, ip); gs[tid] = lf; mm[tid] = ip; }
    { const int rg = tid >> 4, ch0 = (tid & 15) * 8; u32x4 qo[4], ko[4], vv[4];
        if (lc < 64) {
#pragma unroll
            for (int i = 0; i < 4; ++i) { const bf16* zr = zx + (size_t)(lc * 128 + 4 * rg + i) * ZW + h * 128 + ch0; qo[i] = *(const u32x4*)(zr + ZC_Q); ko[i] = *(const u32x4*)(zr + ZC_K); }
        } else {
            const float* wcq = F.in[I_WCONVQK] + (size_t)(l * 2) * 3 * 512 + h * 128; const float* wck = wcq + 3 * 512;
            qk_conv_rows(zx, wcq, lc, rg, ZC_Q + h * 128, ch0, 1.0f, qo); qk_conv_rows(zx, wck, lc, rg, ZC_K + h * 128, ch0, 0.08838834764831845f, ko);
        }
#pragma unroll
        for (int i = 0; i < 4; ++i) vv[i] = *(const u32x4*)(zx + (size_t)(lc * 128 + 4 * rg + i) * ZW + ZC_V + h * 128 + ch0);
#pragma unroll
        for (int i = 0; i < 4; ++i) { const int s_ = 4 * rg + i; *(LAS u32x4*)(Q + s_ * LDT + ch0) = qo[i]; *(LAS u32x4*)(KS + s_ * LDT + ch0) = ko[i]; *(LAS u32x4*)(V + s_ * LDT + ch0) = vv[i]; } }
    __syncthreads();
    if (wave < 2) { const int d = wave; LAS float* gd = gs + d * 128; LAS float* md = mm + d * 128; LAS float* td = mt + d * 128;
        float c0, c1; int i0, i1; (void)mlstm_scan128(gd, d, lane, c0, c1, i0, i1);
        const float g0 = md[i0] - c0, g1 = md[i1] - c1; float p0, p1; scan_max2(g0, g1, lane, p0, p1);
        const float m_in = SCb[((lc * 4 + h) * 2 + d) * 4 + 2];
        const float mm0 = fmaxf(m_in, p0), mm1 = fmaxf(m_in, p1);
        gd[i0] = g0; gd[i1] = g1; md[i0] = mm0; md[i1] = mm1; td[i0] = c0 + mm0; td[i1] = c1 + mm1; }
    f32x4 sraw[8];
#pragma unroll
    for (int n = 0; n < 8; ++n) sraw[n] = (f32x4){0.f, 0.f, 0.f, 0.f};
    mm_lds<8, 4>(sraw, KS + (wave * 16) * LDT, LDT, Q, LDT, 127, lane);
    __syncthreads();
    f32x4 hs[8];
#pragma unroll
    for (int n = 0; n < 8; ++n) hs[n] = (f32x4){0.f, 0.f, 0.f, 0.f};
    const int r0 = wave * 16 + (lane >> 4) * 4, cc = lane & 15;
#pragma unroll 1
    for (int dir = 0; dir < 2; ++dir) {
        const int it = (lc * 4 + h) * 2 + dir;
        const float m_in = SCb[it * 4 + 2];
        {
            const bf16* MST = (const bf16*)(F.ws + WS_MST) + (size_t)it * 16384;
            u32x4 c4[4];
#pragma unroll
            for (int q = 0; q < 4; ++q) { const int idx = q * 512 + tid; c4[q] = *(const u32x4*)(MST + (idx >> 4) * 128 + (idx & 15) * 8); }
#pragma unroll
            for (int q = 0; q < 4; ++q) { const int idx = q * 512 + tid, dd = idx >> 4, e0 = (idx & 15) * 8; *(LAS u32x4*)(C + dd * LDT + e0) = c4[q]; }
            if (tid < 128) nv[tid] = (bf16)f2bf(((const float*)(F.ws + WS_MISC + MS_NST))[it * 128 + tid]);
        }
        const LAS float* gd = gs + dir * 128; const LAS float* md = mm + dir * 128; const LAS float* td = mt + dir * 128;
        {
            float g4[4];
#pragma unroll
            for (int i = 0; i < 4; ++i) g4[i] = gd[r0 + i];
            float mmv[8];
#pragma unroll
            for (int n = 0; n < 8; ++n) mmv[n] = md[n * 16 + cc];
#pragma unroll
            for (int n = 0; n < 8; ++n) { const int t = n * 16 + cc; const float mmt = mmv[n]; float v[4];
#pragma unroll
                for (int i = 0; i < 4; ++i) { const int s_ = r0 + i; const bool ok = dir ? (s_ >= t) : (s_ <= t); v[i] = ok ? sraw[n][i] * __expf(g4[i] - mmt) : 0.f; }
                *(LAS u32x2*)(KS + t * LDT + r0) = (u32x2){pk2(v[0], v[1]), pk2(v[2], v[3])}; } }
        __syncthreads();
        f32x4 ao[8], den = (f32x4){0.f, 0.f, 0.f, 0.f};
#pragma unroll
        for (int n = 0; n < 8; ++n) ao[n] = (f32x4){0.f, 0.f, 0.f, 0.f};
        const LAS bf16* Aq = Q + (wave * 16) * LDT; const LAS bf16* As = KS + (wave * 16) * LDT;
#pragma unroll
        for (int ks = 0; ks < 4; ++ks) { const bf16x8 a = *(const LAS bf16x8*)(Aq + (lane & 15) * LDT + ks * 32 + (lane >> 4) * 8);
            den = __builtin_amdgcn_mfma_f32_16x16x32_bf16(a, *(const LAS bf16x8*)(nv + ks * 32 + (lane >> 4) * 8), den, 0, 0, 0);
            bf16x8 bfr[8];
#pragma unroll
            for (int n = 0; n < 8; ++n) bfr[n] = frag_tr(C, LDT, ks * 32, n * 16, lane);
#pragma unroll
            for (int n = 0; n < 8; ++n) ao[n] = __builtin_amdgcn_mfma_f32_16x16x32_bf16(a, bfr[n], ao[n], 0, 0, 0); }
        float inter[4], emt[4];
#pragma unroll
        for (int i = 0; i < 4; ++i) { inter[i] = __expf(m_in - md[r0 + i]); emt[i] = __expf(-td[r0 + i]); den[i] *= inter[i]; }
#pragma unroll
        for (int n = 0; n < 8; ++n)
#pragma unroll
            for (int i = 0; i < 4; ++i) ao[n][i] *= inter[i];
        const bf16x8 ones = (bf16x8){0x3F80, 0x3F80, 0x3F80, 0x3F80, 0x3F80, 0x3F80, 0x3F80, 0x3F80};
#pragma unroll
        for (int ks = 0; ks < 4; ++ks) { const bf16x8 a = *(const LAS bf16x8*)(As + (lane & 15) * LDT + ks * 32 + (lane >> 4) * 8);
            den = __builtin_amdgcn_mfma_f32_16x16x32_bf16(a, ones, den, 0, 0, 0);
            bf16x8 bfr[8];
#pragma unroll
            for (int n = 0; n < 8; ++n) bfr[n] = frag_tr(V, LDT, ks * 32, n * 16, lane);
#pragma unroll
            for (int n = 0; n < 8; ++n) ao[n] = __builtin_amdgcn_mfma_f32_16x16x32_bf16(a, bfr[n], ao[n], 0, 0, 0); }
#pragma unroll
        for (int i = 0; i < 4; ++i) { const float nr = rcpf_(fmaxf(fabsf(den[i]), emt[i]));
#pragma unroll
            for (int n = 0; n < 8; ++n) hs[n][i] += ao[n][i] * nr; }
        __syncthreads();
    }
    const float* gm = F.in[I_GMH] + l * 512 + h * 128;
    float gmv[8];
#pragma unroll
    for (int n = 0; n < 8; ++n) gmv[n] = gm[n * 16 + cc];
#pragma unroll
    for (int i = 0; i < 4; ++i) { float ss = 0.f;
#pragma unroll
        for (int n = 0; n < 8; ++n) ss += hs[n][i] * hs[n][i];
        const float rstd = __builtin_amdgcn_rsqf(grp16_sum(ss) * (1.0f / 128.0f) + RMS_EPS);
#pragma unroll
        for (int n = 0; n < 8; ++n) Q[(r0 + i) * LDT + n * 16 + cc] = (bf16)f2bf(hs[n][i] * rstd * gmv[n]); }
    __syncthreads();
    u32x4 opre[4];
#pragma unroll
    for (int q = 0; q < 4; ++q) { const int idx = q * 512 + tid; opre[q] = *(const u32x4*)(zx + (size_t)(lc * 128 + (idx >> 4)) * ZW + ZC_O + h * 128 + (idx & 15) * 8); }
#pragma unroll
    for (int q = 0; q < 4; ++q) { const int idx = q * 512 + tid, t = idx >> 4, e0 = (idx & 15) * 8;
        bf16* orow = zx + (size_t)(lc * 128 + t) * ZW + ZC_O + h * 128 + e0;
        const u32x4 o4 = opre[q], h4 = *(const LAS u32x4*)(Q + t * LDT + e0); u32x4 y;
#pragma unroll
        for (int e = 0; e < 4; ++e) y[e] = pk2(bflo(h4[e]) * bflo(o4[e]), bfhi(h4[e]) * bfhi(o4[e]));
        *(u32x4*)orow = y; }
}

__device__ __forceinline__ void sgu_conv_item(Frame& F, int l, int lc) {
    PHASE_IDS();
    bf16* zx = (bf16*)(F.ws + WS_ZX);
    LAS bf16* W = (LAS bf16*)F.lds; LAS bf16* VN = W + 128 * LDT;
    __syncthreads();
    const int t = tid >> 2, part = tid & 3;
    u32x4 gv[16]; float mu, rs;
    { const u32x4* p = (const u32x4*)(zx + (size_t)(lc * 128 + t) * ZW + ZC_SV + part * 128);
        float s1 = 0.f, s2 = 0.f;
#pragma unroll
        for (int q = 0; q < 16; ++q) gv[q] = p[q];
#pragma unroll
        for (int q = 0; q < 16; ++q) {
#pragma unroll
            for (int e = 0; e < 4; ++e) { const float a = bflo(gv[q][e]), b = bfhi(gv[q][e]); s1 += a + b; s2 += a * a + b * b; } }
        s1 += __shfl_xor(s1, 1); s1 += __shfl_xor(s1, 2); s2 += __shfl_xor(s2, 1); s2 += __shfl_xor(s2, 2);
        mu = s1 * (1.0f / 512.0f); rs = __builtin_amdgcn_rsqf(fmaxf(s2 * (1.0f / 512.0f) - mu * mu, 0.f) + RMS_EPS); }
#pragma unroll 1
    for (int sg = 0; sg < 4; ++sg) {
        if (sg) __syncthreads();
        if (part == sg) {
#pragma unroll
            for (int q = 0; q < 16; ++q) { u32x4 o;
#pragma unroll
                for (int e = 0; e < 4; ++e) o[e] = pk2((bflo(gv[q][e]) - mu) * rs, (bfhi(gv[q][e]) - mu) * rs);
                *(LAS u32x4*)(VN + t * LDT + q * 8) = o; } }
        { const float* ws = F.in[I_WSGU] + (size_t)(l * 4 + sg) * 128 * 128;
            f32x4 w4[8];
#pragma unroll
            for (int q = 0; q < 8; ++q) { const int idx = q * 512 + tid; w4[q] = *(const f32x4*)(ws + (idx >> 5) * 128 + (idx & 31) * 4); }
#pragma unroll
            for (int q = 0; q < 8; ++q) { const int idx = q * 512 + tid, tt = idx >> 5, s0 = (idx & 31) * 4;
                *(LAS u32x2*)(W + tt * LDT + s0) = (u32x2){pk2(w4[q][0], w4[q][1]), pk2(w4[q][2], w4[q][3])}; } }
        const int d0 = wave * 16 + (lane >> 4) * 4;
        u32x2 supre[8];
#pragma unroll
        for (int n = 0; n < 8; ++n) supre[n] = *(const u32x2*)(zx + (size_t)(lc * 128 + n * 16 + (lane & 15)) * ZW + ZC_SU + sg * 128 + d0);
        __syncthreads();
        f32x4 acc[8];
#pragma unroll
        for (int n = 0; n < 8; ++n) acc[n] = (f32x4){0.f, 0.f, 0.f, 0.f};
#pragma unroll
        for (int ks = 0; ks < 4; ++ks) { const bf16x8 a = frag_tr(VN, LDT, ks * 32, wave * 16, lane);
            bf16x8 bfr[8];
#pragma unroll
            for (int n = 0; n < 8; ++n) bfr[n] = *(const LAS bf16x8*)(W + (n * 16 + (lane & 15)) * LDT + ks * 32 + (lane >> 4) * 8);
#pragma unroll
            for (int n = 0; n < 8; ++n) acc[n] = __builtin_amdgcn_mfma_f32_16x16x32_bf16(a, bfr[n], acc[n], 0, 0, 0); }
        const f32x4 g4 = *(const f32x4*)(F.in[I_GSGU] + l * 512 + sg * 128 + d0);
        const float* bs = F.in[I_BSGU] + (l * 4 + sg) * 128;
        float btv[8];
#pragma unroll
        for (int n = 0; n < 8; ++n) btv[n] = bs[n * 16 + (lane & 15)];
#pragma unroll
        for (int n = 0; n < 8; ++n) { const int tt = n * 16 + (lane & 15); const float bt = btv[n];
            u32x2* p = (u32x2*)(zx + (size_t)(lc * 128 + tt) * ZW + ZC_SU + sg * 128 + d0); const u32x2 su = supre[n];
            u32x2 o; o.x = pk2(bflo(su.x) * (g4[0] * acc[n][0] + bt), bfhi(su.x) * (g4[1] * acc[n][1] + bt));
            o.y = pk2(bflo(su.y) * (g4[2] * acc[n][2] + bt), bfhi(su.y) * (g4[3] * acc[n][3] + bt));
            *p = o; }
    }
    {
        const int rg = tid >> 4, c8 = (tid & 15) * 8, s0 = 4 * rg; bool hl, hr, d0_, d1_; nbr_flags(lc, s0, hl, d0_); nbr_flags(lc, s0 + 3, d1_, hr);
#pragma unroll 1
        for (int sg = 0; sg < 4; ++sg) { const int ch = sg * 128 + c8;
            float w[24];
#pragma unroll
            for (int j = 0; j < 3; ++j) { const f32x4 w0 = *(const f32x4*)(F.in[I_WSCONV] + (size_t)(l * 3 + j) * 512 + ch), w1 = *(const f32x4*)(F.in[I_WSCONV] + (size_t)(l * 3 + j) * 512 + ch + 4);
#pragma unroll
                for (int e = 0; e < 4; ++e) { w[j * 8 + e] = w0[e]; w[j * 8 + 4 + e] = w1[e]; } }
            const bf16* pc = zx + (size_t)(lc * 128 + s0) * ZW + ZC_CC + ch; const bf16* px = zx + (size_t)(lc * 128 + s0) * ZW + ZC_CX + ch; bf16* pb = zx + (size_t)(lc * 128 + s0) * ZW + ZC_CB + ch;
            u32x4 c[6], x[6], cb[4]; const u32x4 z4 = zero4();
            c[0] = hl ? *(const u32x4*)(pc - ZW) : z4; x[0] = hl ? *(const u32x4*)(px - ZW) : z4;
#pragma unroll
            for (int i = 0; i < 4; ++i) { c[1 + i] = *(const u32x4*)(pc + (size_t)i * ZW); x[1 + i] = *(const u32x4*)(px + (size_t)i * ZW); cb[i] = *(const u32x4*)(pb + (size_t)i * ZW); }
            c[5] = hr ? *(const u32x4*)(pc + (size_t)4 * ZW) : z4; x[5] = hr ? *(const u32x4*)(px + (size_t)4 * ZW) : z4;
            float pl[6][8];
#pragma unroll
            for (int r = 0; r < 6; ++r)
#pragma unroll
                for (int e = 0; e < 4; ++e) { pl[r][2 * e] = bflo(c[r][e]) * bflo(x[r][e]); pl[r][2 * e + 1] = bfhi(c[r][e]) * bfhi(x[r][e]); }
#pragma unroll
            for (int i = 0; i < 4; ++i) { u32x4 o;
#pragma unroll
                for (int e = 0; e < 4; ++e) { const float y0 = bflo(cb[i][e]) * (w[2 * e] * pl[i][2 * e] + w[8 + 2 * e] * pl[i + 1][2 * e] + w[16 + 2 * e] * pl[i + 2][2 * e]);
                    const float y1 = bfhi(cb[i][e]) * (w[2 * e + 1] * pl[i][2 * e + 1] + w[8 + 2 * e + 1] * pl[i + 1][2 * e + 1] + w[16 + 2 * e + 1] * pl[i + 2][2 * e + 1]); o[e] = pk2(y0, y1); }
                *(u32x4*)(pb + (size_t)i * ZW) = o; } }
    }
}

__device__ __forceinline__ void s5_out_item(Frame& F, int l, int lc, int q) {
    PHASE_IDS();
    bf16* zx = (bf16*)(F.ws + WS_ZX);
    LAS bf16* U16 = (LAS bf16*)(F.lds + wave * 10752); LAS bf16* BX = U16 + 32 * 32;
    LAS bf16* Y = (LAS bf16*)(F.lds + 86016);
    constexpr int LDY = 392;
    const int p = lane, row0 = lc * 128 + q * 32;
    const f32x2* E = (const f32x2*)(F.ws + WS_S5E); const f32x2* X = (const f32x2*)(F.ws + WS_MISC + MS_S5X);
    __syncthreads();
    { const int t = lane >> 1, h8 = (lane & 1) * 8; *(LAS u32x4*)(U16 + t * 32 + 16 + h8) = zero4(); }
    f32x4 n_ab4; f32x2 n_ab2, n_x0, n_e0; u32x4 n_bb[8], n_u, n_cf[4]; float n_dj;
#define S5_LOAD_COMBO(c_) do { const int g5_ = wave * 3 + ((c_) >> 1), dir_ = (c_) & 1, qs_ = dir_ ? 3 - q : q; \
        const f32x4 ab4_ = *(const f32x4*)((const float*)(F.ws + WS_S5T + S5T_AB) + (size_t)((dir_ * 24 + g5_) * 64 + p) * 6 - (p & 1) * 2); \
        const f32x2 ab2_ = *(const f32x2*)((const float*)(F.ws + WS_S5T + S5T_AB) + (size_t)((dir_ * 24 + g5_) * 64 + p) * 6 + 4 - (p & 1) * 2); \
        n_ab4 = ab4_; n_ab2 = ab2_; \
        n_x0 = X[((size_t)(lc * 2 + dir_) * 24 + g5_) * 64 + p]; \
        n_e0 = E[((size_t)((lc * 2 + dir_) * 4 + (qs_ > 0 ? qs_ - 1 : 0)) * 24 + g5_) * 64 + p]; \
        const u32x4* bbf_ = (const u32x4*)(F.ws + WS_S5T + S5T_BB) + (size_t)(dir_ * 24 + g5_) * 8 * 64; \
        _Pragma("unroll") for (int pt_ = 0; pt_ < 8; ++pt_) n_bb[pt_] = bbf_[pt_ * 64 + lane]; } while (0)
#define S5_LOAD_GROUP(gi_) do { const int g5_ = wave * 3 + (gi_); const int t_ = lane >> 1, h8_ = (lane & 1) * 8; \
        n_u = *(const u32x4*)(zx + (size_t)(row0 + t_) * ZW + ZC_U + g5_ * 16 + h8_); \
        _Pragma("unroll") for (int ks_ = 0; ks_ < 4; ++ks_) n_cf[ks_] = ((const u32x4*)(F.ws + WS_S5T + S5T_CC))[(g5_ * 4 + ks_) * 64 + lane]; \
        n_dj = F.in[I_S5D][l * 384 + g5_ * 16 + (lane & 15)]; } while (0)
    S5_LOAD_GROUP(0); S5_LOAD_COMBO(0);
    bf16x8 cf[4]; float dj = 0.f; f32x4 ay[2];
#pragma unroll 1
    for (int c = 0; c < 6; ++c) {
        const int g5 = wave * 3 + (c >> 1), dir = c & 1;
        if (dir == 0) {
            { const int t = lane >> 1, h8 = (lane & 1) * 8; *(LAS u32x4*)(U16 + t * 32 + h8) = n_u; }
#pragma unroll
            for (int ks = 0; ks < 4; ++ks) cf[ks] = __builtin_bit_cast(bf16x8, n_cf[ks]);
            dj = n_dj; ay[0] = (f32x4){0.f, 0.f, 0.f, 0.f}; ay[1] = (f32x4){0.f, 0.f, 0.f, 0.f};
        }
        const bool odd = p & 1;
        const float ab_re = odd ? n_ab4[2] : n_ab4[0], ab_im = odd ? n_ab4[3] : n_ab4[1], pr = odd ? n_ab2[0] : n_ab4[2], pi = odd ? n_ab2[1] : n_ab4[3];
        const int qs = dir ? 3 - q : q;
        float xr = n_x0.x, xi = n_x0.y;
        for (int s_ = 0; s_ < qs; ++s_) cmul(xr, xi, pr, pi);
        if (qs > 0) { xr += n_e0.x; xi += n_e0.y; }
        u32x4 bb[8];
#pragma unroll
        for (int pt = 0; pt < 8; ++pt) bb[pt] = n_bb[pt];
        if (c < 5) { S5_LOAD_COMBO(c + 1); if (dir == 1) S5_LOAD_GROUP((c + 1) >> 1); }
        LDS_WAIT(); asm volatile("" ::: "memory");
        {
            const bf16x8 b0 = *(const LAS bf16x8*)(U16 + (lane & 15) * 32 + (lane >> 4) * 8), b1 = *(const LAS bf16x8*)(U16 + (16 + (lane & 15)) * 32 + (lane >> 4) * 8);
#pragma unroll
            for (int pt = 0; pt < 8; ++pt) { const bf16x8 a = __builtin_bit_cast(bf16x8, bb[pt]); const f32x4 z = (f32x4){0.f, 0.f, 0.f, 0.f};
                const f32x4 o0 = __builtin_amdgcn_mfma_f32_16x16x32_bf16(a, b0, z, 0, 0, 0), o1 = __builtin_amdgcn_mfma_f32_16x16x32_bf16(a, b1, z, 0, 0, 0);
                *(LAS u32x2*)(BX + (lane & 15) * LDT + pt * 16 + (lane >> 4) * 4) = (u32x2){pk2(o0[0], o0[1]), pk2(o0[2], o0[3])};
                *(LAS u32x2*)(BX + (16 + (lane & 15)) * LDT + pt * 16 + (lane >> 4) * 4) = (u32x2){pk2(o1[0], o1[1]), pk2(o1[2], o1[3])}; } }
        LDS_WAIT(); asm volatile("" ::: "memory");
        unsigned wv[32];
#pragma unroll
        for (int k = 0; k < 32; ++k) { const int tl = dir ? 31 - k : k; wv[k] = *(const LAS unsigned*)(BX + tl * LDT + 2 * p); }
#pragma unroll
        for (int k = 0; k < 32; ++k) { const float bur = bflo(wv[k]), bui = bfhi(wv[k]);
            const float nr = ab_re * xr - ab_im * xi + bur, ni = ab_re * xi + ab_im * xr + bui; xr = nr; xi = ni; wv[k] = pk2(xr, xi); }
#pragma unroll
        for (int k = 0; k < 32; ++k) { const int tl = dir ? 31 - k : k; *(LAS unsigned*)(BX + tl * LDT + 2 * p) = wv[k]; }
        LDS_WAIT(); asm volatile("" ::: "memory");
        { bf16x8 afr[8];
#pragma unroll
            for (int q8 = 0; q8 < 8; ++q8) afr[q8] = *(const LAS bf16x8*)(BX + ((q8 >> 2) * 16 + (lane & 15)) * LDT + (q8 & 3) * 32 + (lane >> 4) * 8);
#pragma unroll
            for (int q8 = 0; q8 < 8; ++q8) ay[q8 >> 2] = __builtin_amdgcn_mfma_f32_16x16x32_bf16(afr[q8], cf[q8 & 3], ay[q8 >> 2], 0, 0, 0); }
        if (dir == 1) {
            const int j = lane & 15;
#pragma unroll
            for (int tt = 0; tt < 2; ++tt)
#pragma unroll
                for (int i = 0; i < 4; ++i) { const int t = tt * 16 + (lane >> 4) * 4 + i; const float y = geluf_(ay[tt][i] + dj * bf2f(U16[t * 32 + j])); Y[t * LDY + g5 * 16 + j] = (bf16)f2bf(y); }
            LDS_WAIT(); asm volatile("" ::: "memory");
        }
    }
#undef S5_LOAD_COMBO
#undef S5_LOAD_GROUP
    __syncthreads();
    f32x4 az[2][3];
#pragma unroll
    for (int tt = 0; tt < 2; ++tt)
#pragma unroll
        for (int n = 0; n < 3; ++n) az[tt][n] = (f32x4){0.f, 0.f, 0.f, 0.f};
    const bf16* wg = (const bf16*)(F.ws + WS_WGLU);
#pragma unroll 1
    for (int k4 = 0; k4 < 3; ++k4) {
        bf16x8 a[4][2], b[4][3];
#pragma unroll
        for (int kk = 0; kk < 4; ++kk)
#pragma unroll
            for (int n = 0; n < 3; ++n) b[kk][n] = *(const bf16x8*)(wg + (size_t)(wave * 48 + n * 16 + (lane & 15)) * 384 + (k4 * 4 + kk) * 32 + (lane >> 4) * 8);
#pragma unroll
        for (int kk = 0; kk < 4; ++kk)
#pragma unroll
            for (int tt = 0; tt < 2; ++tt) a[kk][tt] = *(const LAS bf16x8*)(Y + (tt * 16 + (lane & 15)) * LDY + (k4 * 4 + kk) * 32 + (lane >> 4) * 8);
        __builtin_amdgcn_sched_barrier(0);
#pragma unroll
        for (int kk = 0; kk < 4; ++kk)
#pragma unroll
            for (int tt = 0; tt < 2; ++tt)
#pragma unroll
                for (int n = 0; n < 3; ++n) az[tt][n] = __builtin_amdgcn_mfma_f32_16x16x32_bf16(a[kk][tt], b[kk][n], az[tt][n], 0, 0, 0);
    }
    const float* bgl = F.in[I_BGLU] + l * 384;
    float bgv[3];
#pragma unroll
    for (int n = 0; n < 3; ++n) bgv[n] = bgl[wave * 48 + n * 16 + (lane & 15)];
#pragma unroll
    for (int tt = 0; tt < 2; ++tt)
#pragma unroll
        for (int n = 0; n < 3; ++n) { const int col = wave * 48 + n * 16 + (lane & 15); const float bb = bgv[n];
#pragma unroll
            for (int i = 0; i < 4; ++i) { const int t = tt * 16 + (lane >> 4) * 4 + i; const float y = bf2f(Y[t * LDY + col]);
                zx[(size_t)(row0 + t) * ZW + ZC_U + col] = (bf16)f2bf(y * sigmoidf_(az[tt][n][i] + bb)); } }
}

__device__ __forceinline__ void zero_cols(Frame& F, int col0, int n8, int nrows) {
    PHASE_IDS();
    bf16* zx = (bf16*)(F.ws + WS_ZX);
    for (int idx = F.vcu * NTHR + tid; idx < nrows * n8; idx += F.G * NTHR) { const int r = idx / n8, c = idx % n8; *(u32x4*)(zx + (size_t)r * ZW + col0 + c * 8) = (u32x4){0u, 0u, 0u, 0u}; }
}
constexpr int CW_QUEUE = 8192;
__device__ __forceinline__ int next_item(Frame& F, int qid, int cur, int tid) {
    volatile LAS unsigned* slot = (volatile LAS unsigned*)(F.lds + MISC_OFF) + 16;
    __syncthreads();
    if (tid == 0) *slot = (unsigned)F.G + __hip_atomic_fetch_add((unsigned*)(F.ws + WS_CTL) + CW_QUEUE + 64 * qid, 1u, __ATOMIC_RELAXED, __HIP_MEMORY_SCOPE_AGENT);
    __syncthreads();
    (void)cur; return (int)*slot;
}
__device__ __forceinline__ void pass1_phase(Frame& F, int l, int qid) {
    constexpr int N_ML = NLC * 4, N_S5 = NLC * 6;
    int tid0 = threadIdx.x; asm volatile("" : "+v"(tid0));
    for (int it = F.vcu; it < N_ML + N_S5; it = next_item(F, qid, it, tid0)) {
        if (it < N_S5) { if (MASK & 8) s5_local_item(F, l, it / 6, it % 6); }
        else if (MASK & 16) { const int r = it - N_S5; mlstm_local_item(F, l, r >> 2, r & 3); }
    }
}
__device__ __forceinline__ void pass2_phase(Frame& F, int l, int nlc, int qid) {
    const int n4 = nlc * 4;
    int tid0 = threadIdx.x; asm volatile("" : "+v"(tid0));
    for (int it = F.vcu; it < 2 * n4 + nlc; it = next_item(F, qid, it, tid0)) {
        if (it < nlc) { if (MASK & 4) sgu_conv_item(F, l, it); }
        else if (it < nlc + n4) { if (MASK & 8) { const int r = it - nlc; s5_out_item(F, l, r >> 2, r & 3); } }
        else if (MASK & 16) { const int r = it - nlc - n4; mlstm_out_item(F, l, r >> 2, r & 3); }
    }
    if (!(MASK & 16)) zero_cols(F, ZC_O, 64, nlc * 128);
    if (!(MASK & 8)) zero_cols(F, ZC_U, 48, nlc * 128);
    if (!(MASK & 4)) { zero_cols(F, ZC_SU, 64, nlc * 128); zero_cols(F, ZC_CB, 64, nlc * 128); }
}

struct EpiStoreBf16 {
    static constexpr bool PERM = true;
    bf16* O;
    __device__ __forceinline__ void operator()(const f32x4 (&acc)[2][2][4][2], const pg8::Unit& u, int wr, int wc, int fr, int fq) const {
        const int row0 = u.pm * 256 + wr * 64 + fr, col0 = u.pn * 256 + wc * 32 + 8 * fq;
        const int act = (u.pn >= 20 || u.pn == 8 || u.pn == 9) ? 1 : ((u.pn >= 10 && u.pn < 14) ? 2 : 0);
#pragma unroll
        for (int ai = 0; ai < 2; ++ai)
#pragma unroll
            for (int m = 0; m < 4; ++m) { bf16* rowp = O + (size_t)(row0 + ai * 128 + m * 16) * ZW + col0;
#pragma unroll
                for (int bj = 0; bj < 2; ++bj) { f32x4 v0 = acc[ai][bj][m][0], v1 = acc[ai][bj][m][1];
                    if (act == 1) {
#pragma unroll
                        for (int e = 0; e < 4; ++e) { v0[e] = sigmoidf_(v0[e]); v1[e] = sigmoidf_(v1[e]); } }
                    else if (act == 2) {
#pragma unroll
                        for (int e = 0; e < 4; ++e) { v0[e] = geluf_(v0[e]); v1[e] = geluf_(v1[e]); } }
                    u32x4 w; w.x = pk2(v0[0], v0[1]); w.y = pk2(v0[2], v0[3]); w.z = pk2(v1[0], v1[1]); w.w = pk2(v1[2], v1[3]);
                    *(u32x4*)(rowp + bj * 128) = w; } }
    }
};
struct EpiGateCat {
    static constexpr bool PERM = true;
    const bf16* zx; bf16* mg;
    __device__ __forceinline__ void rescale(f32x4 (&acc)[2][2][4][2], const pg8::Unit& u, int t, int wr, int wc, int fr, int fq) const {
        const int b = t == 8 ? 0 : (t == 16 ? 1 : 2);
        const int rl0 = u.pm * 256 + wr * 64 + fr, col0 = u.pn * 256 + wc * 32 + 8 * fq;
#pragma unroll
        for (int ai = 0; ai < 2; ++ai) {
            u32x4 ga[4][2], gb[4][2];
#pragma unroll
            for (int m = 0; m < 4; ++m) { const bf16* gp = zx + (size_t)(rl0 + ai * 128 + m * 16) * ZW + ZC_BG + b * 1024 + col0;
#pragma unroll
                for (int bj = 0; bj < 2; ++bj) { ga[m][bj] = *(const u32x4*)(gp + bj * 128); gb[m][bj] = *(const u32x4*)(gp + 1024 + bj * 128); } }
#pragma unroll
            for (int m = 0; m < 4; ++m)
#pragma unroll
                for (int bj = 0; bj < 2; ++bj)
#pragma unroll
                    for (int e = 0; e < 4; ++e) { const int n = e >> 1, c = (e & 1) * 2;
                        acc[ai][bj][m][n][c] *= fmaxf(bflo(ga[m][bj][e]), 1e-20f) * rcpf_(fmaxf(bflo(gb[m][bj][e]), 1e-20f));
                        acc[ai][bj][m][n][c + 1] *= fmaxf(bfhi(ga[m][bj][e]), 1e-20f) * rcpf_(fmaxf(bfhi(gb[m][bj][e]), 1e-20f)); }
            asm volatile("" ::: "memory"); }
    }
    __device__ __forceinline__ void operator()(const f32x4 (&acc)[2][2][4][2], const pg8::Unit& u, int wr, int wc, int fr, int fq) const {
        const int rl0 = u.pm * 256 + wr * 64 + fr, rg0 = u.pmg * 256 + wr * 64 + fr, col0 = u.pn * 256 + wc * 32 + 8 * fq;
#pragma unroll
        for (int ai = 0; ai < 2; ++ai) {
            u32x4 gw[4][2];
#pragma unroll
            for (int m = 0; m < 4; ++m) { const bf16* gp = zx + (size_t)(rl0 + ai * 128 + m * 16) * ZW + ZC_BG + 3 * 1024 + col0;
#pragma unroll
                for (int bj = 0; bj < 2; ++bj) gw[m][bj] = *(const u32x4*)(gp + bj * 128); }
#pragma unroll
            for (int m = 0; m < 4; ++m) { bf16* mp = mg + (size_t)(rg0 + ai * 128 + m * 16) * D + col0;
#pragma unroll
                for (int bj = 0; bj < 2; ++bj) { const u32x4 g_ = gw[m][bj]; const f32x4 v0 = acc[ai][bj][m][0], v1 = acc[ai][bj][m][1]; u32x4 w;
                    w.x = pk2(fmaxf(bflo(g_.x), 1e-20f) * v0[0], fmaxf(bfhi(g_.x), 1e-20f) * v0[1]); w.y = pk2(fmaxf(bflo(g_.y), 1e-20f) * v0[2], fmaxf(bfhi(g_.y), 1e-20f) * v0[3]);
                    w.z = pk2(fmaxf(bflo(g_.z), 1e-20f) * v1[0], fmaxf(bfhi(g_.z), 1e-20f) * v1[1]); w.w = pk2(fmaxf(bflo(g_.w), 1e-20f) * v1[2], fmaxf(bfhi(g_.w), 1e-20f) * v1[3]);
                    *(u32x4*)(mp + bj * 128) = w; } }
            asm volatile("" ::: "memory"); }
    }
};
struct OrderIn {
    const char* hn; const char* win; int g, G, c;
    __device__ __forceinline__ bool next(int i, pg8::Unit& u) const {
        const int L = i * G + c; if (L >= 34 * 36) return false;
        int pm, pn; pg8::tile_of(L, 34, 36, pm, pn);
        u.pm = pm; u.pn = pn; u.pmg = gtile_of(g, pm); u.br = 0; u.nt = 16;
        u.A = hn + (size_t)u.pmg * 256 * D * 2; u.B = win + (size_t)pn * 256 * D * 2; return true;
    }
};
struct OrderUp {
    const char* zx; const char* wup; int g, nOT, G, bx;
    __device__ __forceinline__ bool next(int i, pg8::Unit& u) const {
        if (i > 0) return false;
        const int per = (nOT + 7) >> 3, slot = bx >> 3, ot = (bx & 7) * per + slot; if (slot >= per || ot >= nOT) return false;
        const int pm = ot >> 2, pn = ot & 3;
        u.pm = pm; u.pn = pn; u.pmg = gtile_of(g, pm); u.br = 0; u.nt = 30;
        u.A = zx + (size_t)pm * 256 * ZW * 2; u.B = wup + (size_t)pn * 256 * 1920 * 2; return true;
    }
};

__global__ void __launch_bounds__(NTHR, 2) fwd_kernel(Args args) {
    extern __shared__ __attribute__((aligned(16))) unsigned char lds[];
    Frame F;
    F.lds = (LAS unsigned char*)lds;
    volatile LAS unsigned* MISC = (volatile LAS unsigned*)(F.lds + MISC_OFF);
    const int tid = threadIdx.x;
    F.G = gridDim.x; { const int bx = blockIdx.x; F.vcu = (F.G % 8 == 0) ? (bx % 8) * (F.G / 8) + bx / 8 : bx; }
    F.in = args.in; F.out = args.out; F.ws = args.ws;
    for (int u = tid; u < (LDS_BYTES - LDSCTL_OFF) / 4; u += NTHR) ((LAS unsigned*)(F.lds + LDSCTL_OFF))[u] = 0u;
    __syncthreads();
    unsigned* ctl = (unsigned*)(args.ws + WS_CTL);
    XcdBarrier bar = xcd_barrier_post(ctl + CW_BAR, MISC + 8);
#define GRID_BAR() do { XcdBarrier b_ = bar; asm volatile("" : "+s"(b_.x), "+s"(b_.bar)); xcd_barrier(b_); } while (0)

    p0_mods(F);
    p0_weights(F, 0);
    s5_tables(F, 0);
    GRID_BAR();

    float* xc = (float*)(F.ws + WS_XC);
#pragma unroll 1
    for (int l = 0; l < DEPTH; ++l) {
        asm volatile("" : "+s"(F.ws), "+s"(F.out));
        const bool last = (l == DEPTH - 1);
        const float* xin_l = (l == 0) ? F.in[I_X] : F.out;
        const float* xin_c = (l == 0) ? F.in[I_CTX] : xc;
        const int nMg = ((MASK & 2) && !last) ? 68 : 64;
        if (l > 0) { p0_weights(F, l); s5_tables(F, l); }
        if (MASK & 2) {
            norm_phase(F, xin_l, xin_c, F.in[I_GNMIX] + l * D, l, 0, MTOT);
            GRID_BAR();
#pragma unroll 1
            for (int g = 0; g < NGRP; ++g) {
                asm volatile("" : "+s"(F.ws));
                { OrderIn S{(const char*)(F.ws + WS_HN), (const char*)(F.ws + WS_WIN), g, F.G, (int)blockIdx.x};
                  EpiStoreBf16 E{(bf16*)(F.ws + WS_ZX)};
                  pg8::gemm_phase<EpiStoreBf16, OrderIn, D, D>(F.lds, S, E); }
                GRID_BAR();
                if (MASK & 24) { pass1_phase(F, l, (l * 2 + g) * 2); GRID_BAR(); scan_phase(F, l); GRID_BAR(); }
                pass2_phase(F, l, last ? 64 : 68, (l * 2 + g) * 2 + 1);
                GRID_BAR();
                { OrderUp S{(const char*)(F.ws + WS_ZX), (const char*)(F.ws + WS_WUP), g, (last ? 32 : 34) * 4, F.G, (int)blockIdx.x};
                  EpiGateCat E{(const bf16*)(F.ws + WS_ZX), (bf16*)(F.ws + WS_HN)};
                  pg8::gemm_phase<EpiGateCat, OrderUp, ZW, 1920, true, true, true>(F.lds, S, E); }
                GRID_BAR();
            }
            { OrderGlobal S{(const char*)(F.ws + WS_HN), (const char*)(F.ws + WS_WOUT), D, D, nMg, D / 256, D / 64, F.G, (int)blockIdx.x};
              EpiResid E{xin_l, xin_c, F.out, xc, modp(F, l, 0, 2)};
              pg8::gemm_phase<EpiResid, OrderGlobal, D, D>(F.lds, S, E); }
            GRID_BAR();
        }
        const float* x1_l = (MASK & 2) ? F.out : xin_l; const float* x1_c = (MASK & 2) ? xc : xin_c;
        norm_phase(F, x1_l, x1_c, F.in[I_GNFFN] + l * D, l, 3, nMg * 256);
        GRID_BAR();
        { OrderGlobal S{(const char*)(F.ws + WS_HN), (const char*)(F.ws + WS_WFF1), D, D, nMg, FF2 / 256, D / 64, F.G, (int)blockIdx.x};
          EpiSwiglu E{(bf16*)(F.ws + WS_ZX)};
          pg8::gemm_phase<EpiSwiglu, OrderGlobal, D, D>(F.lds, S, E); }
        GRID_BAR();
        { OrderGlobal S{(const char*)(F.ws + WS_ZX), (const char*)(F.ws + WS_WFF2), FFH, FFH, nMg, D / 256, FFH / 64, F.G, (int)blockIdx.x};
          EpiResid E{x1_l, x1_c, F.out, xc, modp(F, l, 0, 5)};
          pg8::gemm_phase<EpiResid, OrderGlobal, FFH, FFH>(F.lds, S, E); }
        GRID_BAR();
    }
    final_norm_phase(F);
}

extern "C" void kernel_launch(void* const* d_in, const int* in_sizes, int n_in, void* d_out, int out_size, void* d_ws, size_t ws_size, hipStream_t stream) {
    static int grid = 0;
    if (grid == 0) {
        if (n_in != N_IN || ws_size < WS_END || out_size != MLAT * D) { fprintf(stderr, "kernel_launch: unexpected n_in %d / ws %zu / out %d\n", n_in, ws_size, out_size); grid = -1; return; }
        int dev = 0, cus = 0, per_cu = 0;
        if (hipGetDevice(&dev) != hipSuccess || hipDeviceGetAttribute(&cus, hipDeviceAttributeMultiprocessorCount, dev) != hipSuccess) { grid = -1; return; }
        if (hipFuncSetAttribute((const void*)fwd_kernel, hipFuncAttributeMaxDynamicSharedMemorySize, LDS_BYTES) != hipSuccess) { grid = -1; return; }
        if (hipOccupancyMaxActiveBlocksPerMultiprocessor(&per_cu, (const void*)fwd_kernel, NTHR, LDS_BYTES) != hipSuccess || per_cu < 1) { fprintf(stderr, "occupancy query: %d\n", per_cu); grid = -1; return; }
        grid = cus;
    }
    if (grid < 0) return;
    (void)hipMemsetAsync((char*)d_ws + WS_CTL, 0, CTL_ZERO_BYTES, stream);
    Args a{};
    for (int i = 0; i < N_IN; ++i) a.in[i] = (const float*)d_in[i];
    a.out = (float*)d_out; a.ws = (unsigned char*)d_ws;
    void* kargs[] = {&a};
    hipError_t e = hipLaunchCooperativeKernel((const void*)fwd_kernel, dim3(grid), dim3(NTHR), kargs, LDS_BYTES, stream);
    if (e != hipSuccess) fprintf(stderr, "cooperative launch failed: %s (grid %d)\n", hipGetErrorString(e), grid);
}
```
